# Optimizing an MI355X kernel written in HIP

```python
import math
import jax, jax.numpy as jnp
from jax import lax
import numpy as np

D_MODEL = 1024
BATCH = 32
SEQ = 256
DEPTH = 1
DEC_BATCH = 4
DEC_SEQ = 2048
PAST_LEN = 512

GRID_W = 64
N_HEADS = 4
HEAD_DIM = 64
V_DIM = 2 * HEAD_DIM
ATTN_WIDTH = N_HEADS * V_DIM
QK_WIDTH = N_HEADS * 2 * HEAD_DIM
N_FOUR_GROUPS = 4
FOUR_GROUP = 128
FOUR_WIDTH = N_FOUR_GROUPS * FOUR_GROUP
PROJ_WIDTH = 2 * QK_WIDTH + ATTN_WIDTH + FOUR_WIDTH
MIX_WIDTH = ATTN_WIDTH + FOUR_WIDTH
D_FF = 4 * D_MODEL
ROPE_BASE = 10000.0
ROPE_AXIS_DIM = HEAD_DIM // 2
Q_BLOCK = 128
EPS = 1e-6

kernel_name = "hybrid_diffattn_fnet_prefix_dit_step"


def rms_norm(x, g):
    xf = x.astype(jnp.float32)
    y = xf * lax.rsqrt(jnp.mean(xf * xf, axis=-1, keepdims=True) + EPS)
    return (y * g.astype(jnp.float32)).astype(x.dtype)


def adaln(cvec, w_mod, b_mod):
    m = jax.nn.silu(cvec) @ w_mod + b_mod
    return jnp.split(m[:, None, :], 6, axis=-1)


def rope_tables(n):
    rows = n // GRID_W
    row = jnp.broadcast_to(jnp.arange(rows)[:, None], (rows, GRID_W)).reshape(n).astype(jnp.float32)
    col = jnp.broadcast_to(jnp.arange(GRID_W)[None, :], (rows, GRID_W)).reshape(n).astype(jnp.float32)
    inv = ROPE_BASE ** (-jnp.arange(0, ROPE_AXIS_DIM, 2, dtype=jnp.float32) / ROPE_AXIS_DIM)
    ang_r = (row[:, None] * inv)[:, None, None, :]
    ang_c = (col[:, None] * inv)[:, None, None, :]
    return jnp.cos(ang_r), jnp.sin(ang_r), jnp.cos(ang_c), jnp.sin(ang_c)


def rotate_half_pairs(x, cos, sin):
    x1, x2 = jnp.split(x, 2, axis=-1)
    cos = cos.astype(x.dtype)
    sin = sin.astype(x.dtype)
    return jnp.concatenate([x1 * cos - x2 * sin, x2 * cos + x1 * sin], axis=-1)


def apply_axial_rope(x, tables):
    cos_r, sin_r, cos_c, sin_c = tables
    xr, xc = jnp.split(x, 2, axis=-1)
    return jnp.concatenate([rotate_half_pairs(xr, cos_r, sin_r), rotate_half_pairs(xc, cos_c, sin_c)], axis=-1)


def project(h, w_in, q_g, k_g):
    b, n, _ = h.shape
    p = h @ w_in
    q, k, v, f = jnp.split(p, [QK_WIDTH, 2 * QK_WIDTH, 2 * QK_WIDTH + ATTN_WIDTH], axis=-1)
    q = rms_norm(q.reshape(b, n, N_HEADS, 2, HEAD_DIM), q_g)
    k = rms_norm(k.reshape(b, n, N_HEADS, 2, HEAD_DIM), k_g)
    v = v.reshape(b, n, N_HEADS, V_DIM)
    f = f.reshape(b, n, N_FOUR_GROUPS, FOUR_GROUP)
    return q, k, v, f


def diff_lambda(lq1, lk1, lq2, lk2, lam_init):
    l1 = jnp.exp(jnp.sum(lq1.astype(jnp.float32) * lk1.astype(jnp.float32)))
    l2 = jnp.exp(jnp.sum(lq2.astype(jnp.float32) * lk2.astype(jnp.float32)))
    return l1 - l2 + lam_init


def diff_attention(q, k, v, lam):
    b, nq, h, _, dh = q.shape
    nblk = nq // Q_BLOCK
    scale = 1.0 / math.sqrt(dh)
    qb = q.reshape(b, nblk, Q_BLOCK, h, 2, dh).transpose(1, 0, 2, 3, 4, 5)

    def one_block(qblk):
        s = jnp.einsum('bqhmd,bkhmd->bhmqk', qblk, k).astype(jnp.float32) * scale
        p = jax.nn.softmax(s, axis=-1)
        a = p[:, :, 0] - lam * p[:, :, 1]
        return jnp.einsum('bhqk,bkhe->bqhe', a.astype(v.dtype), v)

    o = lax.map(one_block, qb)
    return o.transpose(1, 0, 2, 3, 4).reshape(b, nq, h, V_DIM)


def fourier_mix(f, w_four):
    b, n, _, _ = f.shape
    spec = jnp.fft.fft2(f.astype(jnp.float32), axes=(1, 3), norm='ortho').real.astype(f.dtype)
    return jnp.einsum('bngc,gce->bnge', spec, w_four).reshape(b, n, FOUR_WIDTH)


def merge(attn, four, subln_g, lam_init, w_out):
    b, n = attn.shape[:2]
    a = rms_norm(attn, subln_g) * (1.0 - lam_init)
    return jnp.concatenate([a.reshape(b, n, ATTN_WIDTH), four], axis=-1) @ w_out


def sq_relu_mlp(h, w1, w2):
    return jnp.square(jax.nn.relu(h @ w1)) @ w2


def setup_inputs(seed: int = 0) -> dict:
    key = jax.random.key(seed)
    ks = jax.random.split(key, 24)
    f32 = jnp.float32
    nrm = lambda k, shape, s: (jax.random.normal(k, shape, f32) * s)
    return {
        'x_prompt': nrm(ks[0], (BATCH, SEQ, D_MODEL), 1.0),
        'x_sample': nrm(ks[1], (DEC_BATCH, DEC_SEQ, D_MODEL), 1.0),
        'c': nrm(ks[2], (DEC_BATCH, D_MODEL), 1.0),
        'cache_k': nrm(ks[3], (DEC_BATCH, DEPTH, PAST_LEN, N_HEADS, 2, HEAD_DIM), 1.0),
        'cache_v': nrm(ks[4], (DEC_BATCH, DEPTH, PAST_LEN, N_HEADS, V_DIM), 1.0),
        'c_ctx': nrm(ks[5], (D_MODEL,), 1.0),
        'w_mod': nrm(ks[6], (DEPTH, D_MODEL, 6 * D_MODEL), 0.5 * D_MODEL ** -0.5),
        'b_mod': nrm(ks[7], (DEPTH, 6 * D_MODEL), 0.02),
        'norm1_g': 1.0 + nrm(ks[8], (DEPTH, D_MODEL), 0.02),
        'w_in': nrm(ks[9], (DEPTH, D_MODEL, PROJ_WIDTH), D_MODEL ** -0.5),
        'q_norm_g': 1.0 + nrm(ks[10], (DEPTH, HEAD_DIM), 0.02),
        'k_norm_g': 1.0 + nrm(ks[11], (DEPTH, HEAD_DIM), 0.02),
        'lambda_q1': nrm(ks[12], (DEPTH, HEAD_DIM), 0.1),
        'lambda_k1': nrm(ks[13], (DEPTH, HEAD_DIM), 0.1),
        'lambda_q2': nrm(ks[14], (DEPTH, HEAD_DIM), 0.1),
        'lambda_k2': nrm(ks[15], (DEPTH, HEAD_DIM), 0.1),
        'subln_g': 1.0 + nrm(ks[16], (DEPTH, V_DIM), 0.02),
        'w_four': nrm(ks[17], (DEPTH, N_FOUR_GROUPS, FOUR_GROUP, FOUR_GROUP), FOUR_GROUP ** -0.5),
        'w_out': nrm(ks[18], (DEPTH, MIX_WIDTH, D_MODEL), MIX_WIDTH ** -0.5),
        'norm2_g': 1.0 + nrm(ks[19], (DEPTH, D_MODEL), 0.02),
        'w1': nrm(ks[20], (DEPTH, D_MODEL, D_FF), D_MODEL ** -0.5),
        'w2': nrm(ks[21], (DEPTH, D_FF, D_MODEL), D_FF ** -0.5),
    }


def reference(x_prompt, x_sample, c, cache_k, cache_v, c_ctx, w_mod, b_mod, norm1_g, w_in,
              q_norm_g, k_norm_g, lambda_q1, lambda_k1, lambda_q2, lambda_k2, subln_g,
              w_four, w_out, norm2_g, w1, w2):
    xp = x_prompt
    xs = x_sample
    tables = rope_tables(xs.shape[1])
    new_k, new_v = [], []
    for l in range(DEPTH):
        lam_init = 0.8 - 0.6 * math.exp(-0.3 * l)
        lam = diff_lambda(lambda_q1[l], lambda_k1[l], lambda_q2[l], lambda_k2[l], lam_init)

        sh1, sc1, g1, sh2, sc2, g2 = adaln(c_ctx[None, :], w_mod[l], b_mod[l])
        h = rms_norm(xp, norm1_g[l]) * (1 + sc1) + sh1
        q, k, v, f = project(h, w_in[l], q_norm_g[l], k_norm_g[l])
        attn = diff_attention(q, k, v, lam)
        mix = merge(attn, fourier_mix(f, w_four[l]), subln_g[l], lam_init, w_out[l])
        xp = xp + g1 * mix
        h = rms_norm(xp, norm2_g[l]) * (1 + sc2) + sh2
        xp = xp + g2 * sq_relu_mlp(h, w1[l], w2[l])
        new_k.append(k)
        new_v.append(v)

        sh1, sc1, g1, sh2, sc2, g2 = adaln(c, w_mod[l], b_mod[l])
        h = rms_norm(xs, norm1_g[l]) * (1 + sc1) + sh1
        q, k, v, f = project(h, w_in[l], q_norm_g[l], k_norm_g[l])
        q = apply_axial_rope(q, tables)
        k = apply_axial_rope(k, tables)
        k_all = jnp.concatenate([cache_k[:, l].astype(k.dtype), k], axis=1)
        v_all = jnp.concatenate([cache_v[:, l].astype(v.dtype), v], axis=1)
        attn = diff_attention(q, k_all, v_all, lam)
        mix = merge(attn, fourier_mix(f, w_four[l]), subln_g[l], lam_init, w_out[l])
        xs = xs + g1 * mix
        h = rms_norm(xs, norm2_g[l]) * (1 + sc2) + sh2
        xs = xs + g2 * sq_relu_mlp(h, w1[l], w2[l])

    new_cache_k = jnp.stack(new_k, axis=1)
    new_cache_v = jnp.stack(new_v, axis=1)
    return (xp, xs, new_cache_k, new_cache_v)
```

```cpp
#include <hip/hip_runtime.h>
#include <hip/hip_cooperative_groups.h>
#include <cstdio>
#include <cstdint>
namespace cg = cooperative_groups;

#define LAS __attribute__((address_space(3)))
typedef unsigned short bf16_t;
typedef short bf16x8 __attribute__((ext_vector_type(8)));
typedef float f32x4 __attribute__((ext_vector_type(4)));
typedef float f32x16 __attribute__((ext_vector_type(16)));
typedef unsigned u32x4 __attribute__((ext_vector_type(4)));
typedef unsigned u32x2 __attribute__((ext_vector_type(2)));

#ifndef REPMASK
#define REPMASK 0
#endif
#define NREP(k) (1 + ((REPMASK >> (k)) & 1))
#ifndef ONE_LAUNCH
#define ONE_LAUNCH 1
#endif

constexpr int D = 1024, NTOK = 16384, NCTX = 8192, LSEQ = 2048, CSEQ = 256, PAST = 512, DFF = 4096, PW = 1536  ;
constexpr int NPH = 8;
constexpr float EPS = 1e-6f;
constexpr float QSCALE = 0.125f * 1.4426950408889634f;
constexpr float LAM_INIT = 0.2f;

constexpr size_t MiB = 1u << 20;
constexpr size_t WS_MOD = 0;
constexpr size_t WS_BAR = 256 * 1024;
constexpr size_t WS_BMAX = 512 * 1024;
constexpr size_t WS_BIAS2 = 640 * 1024;
constexpr size_t WS_WIN = 1 * MiB, WS_WOUT = 5 * MiB, WS_W1 = 7 * MiB, WS_W2 = 15 * MiB, WS_MT = 23 * MiB, WS_DFTC = 24 * MiB;
constexpr size_t WS_H = 25 * MiB;
constexpr size_t WS_X2 = WS_H;
constexpr size_t WS_A2 = 57 * MiB;
constexpr size_t WS_P = 57 * MiB;
constexpr size_t WS_FPART = 57 * MiB;
constexpr size_t WS_VT = 105 * MiB;
constexpr size_t WS_U = 121 * MiB;
constexpr size_t WS_DFTL = 121 * MiB;
constexpr size_t WS_KC = 137 * MiB, WS_VTC = 139 * MiB;
constexpr size_t WS_QN = 141 * MiB, WS_KN = 157 * MiB;
constexpr size_t WS_GTL = 173 * MiB;
constexpr size_t WS_GTC = 189 * MiB;
constexpr size_t WS_SSQ = 249 * MiB;
constexpr size_t WS_END = 250 * MiB;

constexpr int LDS_BYTES = 147456;

__device__ __forceinline__ unsigned pk2(float lo, float hi) {
    typedef __bf16 bf2 __attribute__((ext_vector_type(2))); typedef float f2 __attribute__((ext_vector_type(2)));
    f2 v = {lo, hi}; return __builtin_bit_cast(unsigned, __builtin_convertvector(v, bf2));
}
__device__ __forceinline__ float bflo(unsigned w) { return __builtin_bit_cast(float, w << 16); }
__device__ __forceinline__ float bfhi(unsigned w) { return __builtin_bit_cast(float, w & 0xffff0000u); }
__device__ __forceinline__ float wave_sum(float v) {
#pragma unroll
    for (int o = 1; o < 64; o <<= 1) v += __shfl_xor(v, o);
    return v;
}
__device__ __forceinline__ float wave_max(float v) {
#pragma unroll
    for (int o = 1; o < 64; o <<= 1) v = fmaxf(v, __shfl_xor(v, o));
    return v;
}
#define LDS_WAIT() asm volatile("s_waitcnt lgkmcnt(0)" ::: "memory")

namespace pg8 {
constexpr int BM = 256, BK = 64, HALF = 128, HTB = HALF * BK * 2, STAGE_BYTES = 8 * HTB, NXCD = 8, WGM = 8;
__host__ __device__ __forceinline__ int lds_byte(int r, int c) { const int st = (r >> 4) * 2 + (c >> 5), rr = r & 15, cc = c & 31, ob = rr * 64 + cc * 2; return st * 1024 + (ob ^ (((ob >> 9) & 1) << 5)); }
__host__ __device__ __forceinline__ void stage_rc(int b, int& R, int& C) { const int st = b / 1024, sb = b % 1024, swz = sb ^ (((sb >> 9) & 1) << 5); R = (st >> 1) * 16 + swz / 64; C = (st & 1) * 32 + (swz % 64) / 2; }
__host__ __device__ __forceinline__ int perm32(int rho) { const int n = rho >> 4, i = rho & 15; return 8 * (i >> 2) + 4 * n + (i & 3); }

struct Unit { int pm, pn, z, pad; const char* a; const char* b; size_t coff; };
struct Gemm { int lda, ldb, K; };

__device__ __forceinline__ void tile_order(int L, int nM, int nN, int& pm, int& pn) {
    const int nwg = nM * nN; int wgid = L;
    { const int q = nwg / NXCD, r = nwg % NXCD, xcd = wgid % NXCD, off = wgid / NXCD; wgid = (xcd < r ? xcd * (q + 1) : r * (q + 1) + (xcd - r) * q) + off; }
    const int nig = WGM * nN, gid = wgid / nig, fm = gid * WGM, gsz = (nM - fm) < WGM ? (nM - fm) : WGM;
    pm = fm + ((wgid % nig) % gsz); pn = (wgid % nig) / gsz;
}

template <class Epi, class Sched>
__device__ __forceinline__ void gemm_phase(LAS unsigned char* lds, const Gemm g, const Sched& S, const Epi& E) {
    int tid = threadIdx.x; asm volatile("" : "+v"(tid));
    const int wid = __builtin_amdgcn_readfirstlane(tid >> 6), lane = tid & 63, wr = wid >> 2, wc = wid & 3, fr = lane & 15, fq = lane >> 4;
    int K = g.K; asm volatile("" : "+s"(K)); const int nt = K / BK;
    unsigned voffA[2], voffB[2];
#pragma unroll
    for (int i = 0; i < 2; ++i) { int R, C; stage_rc(tid * 16 + i * 8192, R, C); const int Rb = (R & ~31) + perm32(R & 31);
        voffA[i] = (unsigned)(R * g.lda + C) * 2u; voffB[i] = (unsigned)(Rb * g.ldb + C) * 2u; }
    const size_t kstep = (size_t)(BK * 2);
    const size_t hA = (size_t)HALF * g.lda * 2, hB = (size_t)HALF * g.ldb * 2;
    const unsigned ldsw = (unsigned)wid * 1024u;
    const int aoff = lds_byte(wr * 64 + fr, fq * 8), boff = lds_byte(wc * 32 + fr, fq * 8);
#define PG8_SA(b, h) (((b) * 2 + (h)) * HTB)
#define PG8_SB(b, h) ((4 + (b) * 2 + (h)) * HTB)
#define PG8_STAGE(bufoff, gbase, voff) do { _Pragma("unroll") for (int _i = 0; _i < 2; ++_i) \
        __builtin_amdgcn_global_load_lds((const unsigned*)((const char*)(gbase) + (voff)[_i]), (LAS unsigned*)(lds + (bufoff) + ldsw + _i * 8192), 16, 0, 0); } while (0)
#define PG8_LDA(dst, b, h) do { _Pragma("unroll") for (int m = 0; m < 4; ++m) _Pragma("unroll") for (int k = 0; k < 2; ++k) dst[m][k] = *(const LAS bf16x8*)(lds + PG8_SA(b, h) + aoff + m * 2048 + k * 1024); } while (0)
#define PG8_LDB(dst, b, h) do { _Pragma("unroll") for (int n = 0; n < 2; ++n) _Pragma("unroll") for (int k = 0; k < 2; ++k) dst[n][k] = *(const LAS bf16x8*)(lds + PG8_SB(b, h) + boff + n * 2048 + k * 1024); } while (0)
#define PG8_MMA(ai, bj, At, Bt) do { __builtin_amdgcn_s_setprio(1); _Pragma("unroll") for (int m = 0; m < 4; ++m) _Pragma("unroll") for (int n = 0; n < 2; ++n) _Pragma("unroll") for (int k = 0; k < 2; ++k) \
        acc[ai][bj][m][n] = __builtin_amdgcn_mfma_f32_16x16x32_bf16(Bt[n][k], At[m][k], acc[ai][bj][m][n], 0, 0, 0); __builtin_amdgcn_s_setprio(0); } while (0)
#define PG8_WAIT_V(n) asm volatile("s_waitcnt vmcnt(" #n ")" ::: "memory")
#define PG8_WAIT_L(n) asm volatile("s_waitcnt lgkmcnt(" #n ")" ::: "memory")
#define PG8_BAR __builtin_amdgcn_s_barrier()
#define PG8_SCHED __builtin_amdgcn_sched_barrier(0)
    Unit cur, nxt; int ui = 0;
    if (!S.next(0, cur)) return;
    f32x4 acc[2][2][4][2];
#pragma unroll
    for (int a = 0; a < 2; ++a)
#pragma unroll
        for (int b = 0; b < 2; ++b)
#pragma unroll
            for (int m = 0; m < 4; ++m)
#pragma unroll
                for (int n = 0; n < 2; ++n) acc[a][b][m][n] = (f32x4){0.f, 0.f, 0.f, 0.f};
    bf16x8 At[4][2], B0[2][2], B1[2][2];
    const char* cA = cur.a; const char* cB = cur.b;
    PG8_STAGE(PG8_SB(0, 0), cB, voffB); PG8_STAGE(PG8_SB(0, 1), cB + hB, voffB); PG8_STAGE(PG8_SA(0, 0), cA, voffA); PG8_STAGE(PG8_SA(0, 1), cA + hA, voffA);
    if (wr == 1) PG8_BAR;
    PG8_WAIT_V(2); PG8_BAR;
    PG8_STAGE(PG8_SB(1, 0), cB + kstep, voffB); PG8_STAGE(PG8_SA(1, 0), cA + kstep, voffA); PG8_STAGE(PG8_SB(1, 1), cB + hB + kstep, voffB);
    PG8_WAIT_V(6); PG8_BAR;
    for (;;) {
        const bool has_next = S.next(ui + 1, nxt);
        const char* nA = has_next ? nxt.a : cA; const char* nB = has_next ? nxt.b : cB;
        for (int t = 0; t < nt; t += 2) {
            const bool last = (t == nt - 2);
            const char* a1 = cA + (size_t)(t + 1) * kstep;
            const char* a2 = last ? nA : cA + (size_t)(t + 2) * kstep; const char* b2 = last ? nB : cB + (size_t)(t + 2) * kstep;
            const char* a3 = a2 + kstep; const char* b3 = b2 + kstep;
            PG8_LDB(B0, 0, 0); PG8_LDB(B1, 0, 1); PG8_SCHED; PG8_LDA(At, 0, 0); PG8_STAGE(PG8_SA(1, 1), a1 + hA, voffA);
            PG8_WAIT_V(8); PG8_WAIT_L(0); PG8_BAR; PG8_MMA(0, 0, At, B0); PG8_MMA(0, 1, At, B1); PG8_BAR; PG8_SCHED;
            PG8_LDA(At, 0, 1); PG8_STAGE(PG8_SB(0, 0), b2, voffB); PG8_STAGE(PG8_SB(0, 1), b2 + hB, voffB); PG8_STAGE(PG8_SA(0, 0), a2, voffA);
            PG8_WAIT_V(8); PG8_WAIT_L(0); PG8_BAR; PG8_MMA(1, 0, At, B0); PG8_MMA(1, 1, At, B1); PG8_BAR; PG8_SCHED;
            PG8_LDB(B0, 1, 0); PG8_LDB(B1, 1, 1); PG8_SCHED; PG8_LDA(At, 1, 0); PG8_STAGE(PG8_SA(0, 1), a2 + hA, voffA);
            PG8_WAIT_V(8); PG8_WAIT_L(0); PG8_BAR; PG8_MMA(0, 0, At, B0); PG8_MMA(0, 1, At, B1); PG8_BAR; PG8_SCHED;
            PG8_LDA(At, 1, 1); PG8_STAGE(PG8_SB(1, 0), b3, voffB); PG8_STAGE(PG8_SB(1, 1), b3 + hB, voffB); PG8_STAGE(PG8_SA(1, 0), a3, voffA);
            PG8_WAIT_V(8); PG8_WAIT_L(0); PG8_BAR; PG8_MMA(1, 0, At, B0); PG8_MMA(1, 1, At, B1); PG8_BAR; PG8_SCHED;
        }
        if (wr == 0) PG8_BAR;
        E(acc, cur, wr, wc, fr, fq);
        if (!has_next) break;
#pragma unroll
        for (int a = 0; a < 2; ++a)
#pragma unroll
            for (int b = 0; b < 2; ++b)
#pragma unroll
                for (int m = 0; m < 4; ++m)
#pragma unroll
                    for (int n = 0; n < 2; ++n) acc[a][b][m][n] = (f32x4){0.f, 0.f, 0.f, 0.f};
        cur = nxt; cA = nA; cB = nB; ++ui;
        if (wr == 1) PG8_BAR;
    }
    PG8_WAIT_V(0);
    PG8_BAR;
#undef PG8_SA
#undef PG8_SB
#undef PG8_STAGE
#undef PG8_LDA
#undef PG8_LDB
#undef PG8_MMA
#undef PG8_WAIT_V
#undef PG8_WAIT_L
#undef PG8_BAR
#undef PG8_SCHED
}
}
using pg8::Unit;

__device__ __forceinline__ u32x4 pack8(const f32x4 v0, const f32x4 v1) { u32x4 w; w.x = pk2(v0[0], v0[1]); w.y = pk2(v0[2], v0[3]); w.z = pk2(v1[0], v1[1]); w.w = pk2(v1[2], v1[3]); return w; }

template <int ACT> struct EpiPlain {
    bf16_t* O; int ldc;
    __device__ __forceinline__ void operator()(const f32x4 (&acc)[2][2][4][2], const Unit& u, int wr, int wc, int fr, int fq) const {
        bf16_t* base = O + u.coff + (size_t)(wr * 64 + fr) * ldc + wc * 32 + 8 * fq;
#pragma unroll
        for (int ai = 0; ai < 2; ++ai)
#pragma unroll
            for (int m = 0; m < 4; ++m) { bf16_t* rowp = base + (size_t)(ai * 128 + m * 16) * ldc;
#pragma unroll
                for (int bj = 0; bj < 2; ++bj) { f32x4 v0 = acc[ai][bj][m][0], v1 = acc[ai][bj][m][1];
                    if (ACT == 1) {
#pragma unroll
                        for (int j = 0; j < 4; ++j) { const float a = fmaxf(v0[j], 0.f), b = fmaxf(v1[j], 0.f); v0[j] = a * a; v1[j] = b * b; } }
                    *(u32x4*)(rowp + bj * 128) = pack8(v0, v1); } }
    }
};

struct EpiInproj {
    bf16_t* Pf; bf16_t* Vt; float* ncv; bf16_t* Qn; bf16_t* Kn; float* nck; const float* qg; const float* kg; LAS float* xch  ;
    __device__ __forceinline__ void operator()(const f32x4 (&acc)[2][2][4][2], const Unit& u, int wr, int wc, int fr, int fq) const {
        if (u.z == 1) {
            const int vr0 = (u.pn - 4) * 256 + wr * 64 + fr, tok0 = u.pm * 256 + wc * 32 + 8 * fq;
            const bool ctx = (u.pm < 32);
#pragma unroll
            for (int ai = 0; ai < 2; ++ai)
#pragma unroll
                for (int m = 0; m < 4; ++m) { const int vr = vr0 + ai * 128 + m * 16;
#pragma unroll
                    for (int bj = 0; bj < 2; ++bj) { const int tok = tok0 + bj * 128; const f32x4 v0 = acc[ai][bj][m][0], v1 = acc[ai][bj][m][1];
                        *(u32x4*)(Vt + (size_t)vr * NTOK + tok) = pack8(v0, v1);
                        if (ctx) { float* o = ncv + (size_t)tok * 512 + vr;
#pragma unroll
                            for (int j = 0; j < 4; ++j) { __builtin_nontemporal_store(v0[j], o + (size_t)j * 512); __builtin_nontemporal_store(v1[j], o + (size_t)(j + 4) * 512); } } } }
            return;
        }
        if (u.pn >= 6) { EpiPlain<0> e{Pf, 512}; e(acc, u, wr, wc, fr, fq); return; }
        const bool isk = u.pn >= 2, lat = u.pm >= 32; const int part = wc & 1, wid = wr * 4 + wc;
        float g8[2][4];
#pragma unroll
        for (int n = 0; n < 2; ++n)
#pragma unroll
            for (int j = 0; j < 4; ++j) g8[n][j] = (isk ? kg : qg)[32 * part + 8 * fq + 4 * n + j];
        float ssv[2][4][2];
#pragma unroll
        for (int ai = 0; ai < 2; ++ai)
#pragma unroll
            for (int m = 0; m < 4; ++m)
#pragma unroll
                for (int bj = 0; bj < 2; ++bj) { const f32x4 v0 = acc[ai][bj][m][0], v1 = acc[ai][bj][m][1];
                    float sq = (v0.x * v0.x + v0.y * v0.y) + (v0.z * v0.z + v0.w * v0.w) + (v1.x * v1.x + v1.y * v1.y) + (v1.z * v1.z + v1.w * v1.w);
                    sq += __shfl_xor(sq, 16); sq += __shfl_xor(sq, 32); ssv[ai][m][bj] = sq;
                    if (fq == 0) xch[wid * 256 + (ai * 8 + m * 2 + bj) * 16 + fr] = sq; }
        asm volatile("s_waitcnt lgkmcnt(0)" ::: "memory"); __builtin_amdgcn_s_barrier();
        const LAS float* px = xch + (wid ^ 1) * 256;
        float inv8[2][4];
#pragma unroll
        for (int n = 0; n < 2; ++n)
#pragma unroll
            for (int j = 0; j < 4; ++j) inv8[n][j] = exp2f(-(float)(8 * (fq & 1) + 4 * n + j) * (13.287712379549449f / 16.f));
#pragma unroll
        for (int ai = 0; ai < 2; ++ai)
#pragma unroll
            for (int m = 0; m < 4; ++m) { const int r = ai * 128 + wr * 64 + m * 16 + fr; const int T = u.pm * 256 + r;
                const int ntok = (T - NCTX) & (LSEQ - 1); const float pos = (float)(part ? (ntok & 63) : (ntok >> 6));
#pragma unroll
                for (int bj = 0; bj < 2; ++bj) {
                    const float tot = ssv[ai][m][bj] + px[(ai * 8 + m * 2 + bj) * 16 + fr]; const float rstd = rsqrtf(tot * (1.f / 64.f) + EPS);
                    float y[2][4];
#pragma unroll
                    for (int n = 0; n < 2; ++n)
#pragma unroll
                        for (int j = 0; j < 4; ++j) y[n][j] = acc[ai][bj][m][n][j] * rstd * g8[n][j];
                    if (lat) {
#pragma unroll
                        for (int n = 0; n < 2; ++n)
#pragma unroll
                            for (int j = 0; j < 4; ++j) { float sn, cs; __sincosf(pos * inv8[n][j], &sn, &cs); const float pv = __shfl_xor(y[n][j], 32);
                                y[n][j] = (fq >= 2) ? (y[n][j] * cs + pv * sn) : (y[n][j] * cs - pv * sn); }
                    }
                    const size_t o = (size_t)T * 512 + (u.pn & 1) * 256 + bj * 128 + wc * 32 + 8 * fq;
                    if (isk) {
                        u32x4 w; w.x = pk2(y[0][0], y[0][1]); w.y = pk2(y[0][2], y[0][3]); w.z = pk2(y[1][0], y[1][1]); w.w = pk2(y[1][2], y[1][3]);
                        *(u32x4*)(Kn + o) = w;
                        if (!lat) { __builtin_nontemporal_store((f32x4){y[0][0], y[0][1], y[0][2], y[0][3]}, (f32x4*)(nck + o)); __builtin_nontemporal_store((f32x4){y[1][0], y[1][1], y[1][2], y[1][3]}, (f32x4*)(nck + o + 4)); }
                    } else {
                        u32x4 w; w.x = pk2(y[0][0] * QSCALE, y[0][1] * QSCALE); w.y = pk2(y[0][2] * QSCALE, y[0][3] * QSCALE); w.z = pk2(y[1][0] * QSCALE, y[1][1] * QSCALE); w.w = pk2(y[1][2] * QSCALE, y[1][3] * QSCALE);
                        *(u32x4*)(Qn + o) = w;
                    }
                } }
    }
};

struct EpiFourLocal {
    bf16_t* GtC; bf16_t* GtL;
    __device__ __forceinline__ void operator()(const f32x4 (&acc)[2][2][4][2], const Unit& u, int wr, int wc, int fr, int fq) const {
        const int g = u.pn, tt = u.pm; bf16_t* base; int ld, csoff;
        if (tt < 32) { base = GtC + (size_t)((tt * 4 + g) * 128) * 512; ld = 512; csoff = 256; }
        else { const int lt = tt - 32, b = lt >> 3; base = GtL + (size_t)((b * 4 + g) * 128) * 4096 + (lt & 7) * 256; ld = 4096; csoff = 2048; }
        base += wc * 32 + 8 * fq;
#pragma unroll
        for (int ai = 0; ai < 2; ++ai)
#pragma unroll
            for (int m = 0; m < 4; ++m) { const int e = wr * 64 + m * 16 + fr; bf16_t* rowp = base + (size_t)e * ld + ai * csoff;
#pragma unroll
                for (int bj = 0; bj < 2; ++bj) *(u32x4*)(rowp + bj * 128) = pack8(acc[ai][bj][m][0], acc[ai][bj][m][1]); }
    }
};

struct EpiResid {
    const float* Rlo; const float* Rhi; const float* gate  ; float* out;
    __device__ __forceinline__ void operator()(const f32x4 (&acc)[2][2][4][2], const Unit& u, int wr, int wc, int fr, int fq) const {
        const int T0 = u.pm * 256; const int mi = (T0 < NCTX) ? 0 : 1 + ((T0 - NCTX) >> 11);
        const float* R = (T0 < NCTX) ? Rlo + (size_t)T0 * D : Rhi + (size_t)(T0 - NCTX) * D;
        const int c0 = u.pn * 256 + wc * 32 + 8 * fq;
        f32x4 gv[2][2];
#pragma unroll
        for (int bj = 0; bj < 2; ++bj)
#pragma unroll
            for (int n = 0; n < 2; ++n) gv[bj][n] = *(const f32x4*)(gate + (size_t)mi * 6144 + c0 + bj * 128 + 4 * n);
#pragma unroll
        for (int ai = 0; ai < 2; ++ai)
#pragma unroll
        for (int mh = 0; mh < 2; ++mh) {
            f32x4 rv[2][2][2];
#pragma unroll
            for (int ml = 0; ml < 2; ++ml)
#pragma unroll
                for (int bj = 0; bj < 2; ++bj) { const size_t off = (size_t)(ai * 128 + wr * 64 + (2 * mh + ml) * 16 + fr) * D + c0 + bj * 128;
                    rv[ml][bj][0] = __builtin_nontemporal_load((const f32x4*)(R + off)); rv[ml][bj][1] = __builtin_nontemporal_load((const f32x4*)(R + off + 4)); }
#pragma unroll
            for (int ml = 0; ml < 2; ++ml)
#pragma unroll
                for (int bj = 0; bj < 2; ++bj) { const int m = 2 * mh + ml; const size_t off = (size_t)(ai * 128 + wr * 64 + m * 16 + fr) * D + c0 + bj * 128;
                    __builtin_nontemporal_store(rv[ml][bj][0] + gv[bj][0] * acc[ai][bj][m][0], (f32x4*)(out + (size_t)T0 * D + off));
                    __builtin_nontemporal_store(rv[ml][bj][1] + gv[bj][1] * acc[ai][bj][m][1], (f32x4*)(out + (size_t)T0 * D + off + 4)); }
        }
    }
};

struct EpiOut {
    const float* xlo; const float* xhi; const float* mod; const float* n2g; float* out; bf16_t* A2; float* ssq;
    __device__ __forceinline__ void operator()(const f32x4 (&acc)[2][2][4][2], const Unit& u, int wr, int wc, int fr, int fq) const {
        const int T0 = u.pm * 256; const int mi = (T0 < NCTX) ? 0 : 1 + ((T0 - NCTX) >> 11);
        const float* R = (T0 < NCTX) ? xlo + (size_t)T0 * D : xhi + (size_t)(T0 - NCTX) * D;
        const int c0 = u.pn * 256 + wc * 32 + 8 * fq; const float* mrow = mod + (size_t)mi * 6144;
        f32x4 gv[2][2], gm[2][2];
#pragma unroll
        for (int bj = 0; bj < 2; ++bj)
#pragma unroll
            for (int n = 0; n < 2; ++n) { const int c = c0 + bj * 128 + 4 * n; gv[bj][n] = *(const f32x4*)(mrow + 2048 + c); gm[bj][n] = *(const f32x4*)(n2g + c) * (*(const f32x4*)(mrow + 4096 + c) + 1.0f); }
#pragma unroll
        for (int ai = 0; ai < 2; ++ai)
#pragma unroll
            for (int m = 0; m < 4; ++m) { const int r = ai * 128 + wr * 64 + m * 16 + fr; float ss = 0.f;
#pragma unroll
                for (int bj = 0; bj < 2; ++bj) { const size_t off = (size_t)r * D + c0 + bj * 128;
                    const f32x4 x0 = __builtin_nontemporal_load((const f32x4*)(R + off)) + gv[bj][0] * acc[ai][bj][m][0], x1 = __builtin_nontemporal_load((const f32x4*)(R + off + 4)) + gv[bj][1] * acc[ai][bj][m][1];
                    __builtin_nontemporal_store(x0, (f32x4*)(out + (size_t)T0 * D + off)); __builtin_nontemporal_store(x1, (f32x4*)(out + (size_t)T0 * D + off + 4));
                    ss += (x0.x * x0.x + x0.y * x0.y) + (x0.z * x0.z + x0.w * x0.w) + (x1.x * x1.x + x1.y * x1.y) + (x1.z * x1.z + x1.w * x1.w);
                    *(u32x4*)(A2 + (size_t)T0 * D + off) = pack8(x0 * gm[bj][0], x1 * gm[bj][1]); }
                ss += __shfl_xor(ss, 16); ss += __shfl_xor(ss, 32);
                if (fq == 0) ssq[(size_t)(T0 + r) * 16 + u.pn * 4 + wc] = ss; }
    }
};

struct EpiUp {
    bf16_t* U; const float* ssq; const float* bias2;
    __device__ __forceinline__ void operator()(const f32x4 (&acc)[2][2][4][2], const Unit& u, int wr, int wc, int fr, int fq) const {
        const int T0 = u.pm * 256; const int mi = (T0 < NCTX) ? 0 : 1 + ((T0 - NCTX) >> 11);
        const int c0 = u.pn * 256 + wc * 32 + 8 * fq;
        f32x4 bv[2][2];
#pragma unroll
        for (int bj = 0; bj < 2; ++bj)
#pragma unroll
            for (int n = 0; n < 2; ++n) bv[bj][n] = *(const f32x4*)(bias2 + (size_t)mi * DFF + c0 + bj * 128 + 4 * n);
        float rs[2][4];
#pragma unroll
        for (int ai = 0; ai < 2; ++ai)
#pragma unroll
            for (int m = 0; m < 4; ++m) { const f32x4* sp = (const f32x4*)(ssq + (size_t)(T0 + ai * 128 + wr * 64 + m * 16 + fr) * 16); const f32x4 s4 = (sp[0] + sp[1]) + (sp[2] + sp[3]);
                rs[ai][m] = rsqrtf(((s4.x + s4.y) + (s4.z + s4.w)) * (1.f / D) + EPS); }
#pragma unroll
        for (int ai = 0; ai < 2; ++ai)
#pragma unroll
            for (int m = 0; m < 4; ++m) { const int r = ai * 128 + wr * 64 + m * 16 + fr;
                const float rstd = rs[ai][m];
                bf16_t* rowp = U + (size_t)(T0 + r) * DFF + c0;
#pragma unroll
                for (int bj = 0; bj < 2; ++bj) { f32x4 v0 = acc[ai][bj][m][0] * rstd + bv[bj][0], v1 = acc[ai][bj][m][1] * rstd + bv[bj][1];
#pragma unroll
                    for (int j = 0; j < 4; ++j) { const float a = fmaxf(v0[j], 0.f), b = fmaxf(v1[j], 0.f); v0[j] = a * a; v1[j] = b * b; }
                    *(u32x4*)(rowp + bj * 128) = pack8(v0, v1); } }
    }
};

struct SchedStd {
    const char* A; const char* B; int nM, nN; size_t atile, btile  ; int ldc; int G, c;
    __device__ __forceinline__ bool next(int i, Unit& u) const {
        const int L = i * G + c; if (L >= nM * nN) return false;
        pg8::tile_order(L, nM, nN, u.pm, u.pn); u.z = 0; u.pad = 0;
        u.a = A + (size_t)u.pm * atile; u.b = B + (size_t)u.pn * btile; u.coff = (size_t)u.pm * 256 * ldc + (size_t)u.pn * 256; return true;
    }
};
__device__ __forceinline__ bool inproj_slot(int i, int G, int c, int& pm, int& pn) {
    const int vcu = (G % 8 == 0) ? (c % 8) * (G / 8) + c / 8 : c; const int s = i * G + vcu; if (s >= 512) return false;
    pm = (s & 255) >> 2; pn = 4 * (s >> 8) + (s & 3); return true;
}
struct SchedInproj {
    const char* H; const char* W; int G, c;
    __device__ __forceinline__ bool next(int i, Unit& u) const {
        if (!inproj_slot(i, G, c, u.pm, u.pn)) return false; u.pad = 0;
        const char* h = H + (size_t)u.pm * 256 * D * 2; const char* w = W + (size_t)u.pn * 256 * D * 2;
        if (u.pn == 4 || u.pn == 5) { u.z = 1; u.a = w; u.b = h; u.coff = 0; }
        else { u.z = 0; u.a = h; u.b = w; u.coff = (size_t)u.pm * 256 * 512 + (size_t)(u.pn >= 6 ? u.pn - 6 : 0) * 256; }
        return true;
    }
};
struct SchedFourChain {
    const char* Mt; const char* Pf; int G, c;
    __device__ __forceinline__ bool next(int j, Unit& u) const {
        int nf = 0, pm, pn;
        for (int i = 0; inproj_slot(i, G, c, pm, pn); ++i) {
            if (pn >= 6) { if ((j >> 1) == nf) { const int g = 2 * (pn - 6) + (j & 1); u.pm = pm; u.pn = g; u.z = 0; u.pad = 0; u.coff = 0;
                    u.a = Mt + (size_t)g * 256 * 128 * 2; u.b = Pf + ((size_t)pm * 256 * 512 + g * 128) * 2; return true; }
                ++nf; } }
        return false;
    }
};
struct SchedPosL {
    const char* Dft; const char* Gt; int G, c;
    __device__ __forceinline__ bool next(int i, Unit& u) const {
        const int L = i * G + c; if (L >= 256) return false;
        u.z = L & 3; const int t = L >> 2; u.pm = t & 7; u.pn = t >> 3; u.pad = 0;
        u.a = Dft + ((size_t)u.pm * 256 * 2048 + u.z * 512) * 2; u.b = Gt + ((size_t)u.pn * 256 * 4096 + (u.pm >= 4 ? 2048 : 0) + u.z * 512) * 2;
        u.coff = (size_t)u.z * 2048 * 2048 + (size_t)u.pm * 256 * 2048 + u.pn * 256; return true;
    }
};
struct SchedPosC {
    const char* Dft; const char* Gt; int G, c;
    __device__ __forceinline__ bool next(int i, Unit& u) const {
        const int L = i * G + c; if (L >= 64) return false;
        u.pm = 0; u.pn = L; u.z = 0; u.pad = 0; u.a = Dft; u.b = Gt + (size_t)L * 256 * 512 * 2;
        u.coff = (size_t)(L >> 1) * 256 * D + 512 + (L & 1) * 256; return true;
    }
};

struct TrItem { const float* W; bf16_t* WT; int K, N, item; };
__device__ __forceinline__ void transpose_load(const TrItem& t, f32x4 (&v)[8], int lane) {
    const int nblk = t.N / 32, kb = t.item / nblk, nb = t.item % nblk, k0 = 64 * kb, n0 = 32 * nb;
#pragma unroll
    for (int i = 0; i < 8; ++i) v[i] = __builtin_nontemporal_load((const f32x4*)(t.W + (size_t)(k0 + 8 * i + (lane >> 3)) * t.N + n0 + (lane & 7) * 4));
}
__device__ __forceinline__ void transpose_store(const TrItem& t, const f32x4 (&v)[8], LAS float* scr, int lane) {
    const int nblk = t.N / 32, kb = t.item / nblk, nb = t.item % nblk, k0 = 64 * kb, n0 = 32 * nb;
#pragma unroll
    for (int i = 0; i < 8; ++i) { LAS float* d = scr + (8 * i + (lane >> 3)) * 33 + (lane & 7) * 4; d[0] = v[i].x; d[1] = v[i].y; d[2] = v[i].z; d[3] = v[i].w; }
    LDS_WAIT(); asm volatile("" ::: "memory");
    const int c = lane & 7;
#pragma unroll
    for (int j = 0; j < 4; ++j) { const int n = (lane >> 3) + 8 * j; const LAS float* s = scr + (8 * c) * 33 + n;
        u32x4 o; o.x = pk2(s[0 * 33], s[1 * 33]); o.y = pk2(s[2 * 33], s[3 * 33]); o.z = pk2(s[4 * 33], s[5 * 33]); o.w = pk2(s[6 * 33], s[7 * 33]);
        *(u32x4*)(t.WT + (size_t)(n0 + n) * t.K + k0 + 8 * c) = o; }
    LDS_WAIT(); asm volatile("" ::: "memory");
}

struct Args {
    const float *x_prompt, *x_sample, *c, *cache_k, *cache_v, *c_ctx, *w_mod, *b_mod, *norm1_g, *w_in, *q_norm_g, *k_norm_g, *lq1, *lk1, *lq2, *lk2, *subln_g, *w_four, *w_out, *norm2_g, *w1, *w2;
    float* out; unsigned char* ws; int ph_lo, ph_hi;
};

__device__ __forceinline__ void rowpass_h(const float* xlo, const float* xhi, const float* gvec, const float* mod, int sh_off, int sc_off, bf16_t* H, int gw, int NGW, int lane) {
    for (int T0 = gw * 8; T0 < NTOK; T0 += NGW * 8) {
        const float* xr = (T0 < NCTX) ? xlo + (size_t)T0 * D : xhi + (size_t)(T0 - NCTX) * D;
        const int mi = (T0 < NCTX) ? 0 : 1 + ((T0 - NCTX) >> 11);
        const float* mrow = mod + (size_t)mi * 6144;
        f32x4 gm[4], sh[4], v[8][4];
#pragma unroll
        for (int k = 0; k < 8; ++k)
#pragma unroll
            for (int j = 0; j < 4; ++j) v[k][j] = __builtin_nontemporal_load((const f32x4*)(xr + (size_t)k * D) + lane + 64 * j);
#pragma unroll
        for (int j = 0; j < 4; ++j) { const int cidx = 4 * (lane + 64 * j);
            gm[j] = *(const f32x4*)(gvec + cidx) * (*(const f32x4*)(mrow + sc_off + cidx) + 1.0f); sh[j] = *(const f32x4*)(mrow + sh_off + cidx); }
#pragma unroll
        for (int k = 0; k < 8; ++k) {
            float ss = 0.f;
#pragma unroll
            for (int j = 0; j < 4; ++j) ss += (v[k][j].x * v[k][j].x + v[k][j].y * v[k][j].y) + (v[k][j].z * v[k][j].z + v[k][j].w * v[k][j].w);
            const float rstd = rsqrtf(wave_sum(ss) * (1.f / D) + EPS);
#pragma unroll
            for (int j = 0; j < 4; ++j) { const int cidx = 4 * (lane + 64 * j);
                const f32x4 o = v[k][j] * rstd * gm[j] + sh[j];
                u32x2 w; w.x = pk2(o.x, o.y); w.y = pk2(o.z, o.w);
                *(u32x2*)(H + (size_t)(T0 + k) * D + cidx) = w; }
        }
    }
}

struct AttnSeg { const bf16_t* K; const bf16_t* Vt; int vstride; int ntiles; };
constexpr int AT_KB = 34816  , AT_VB = 34816  , AT_K0 = 0, AT_V0 = 2 * AT_KB;
__device__ __forceinline__ void attn_unit(LAS unsigned char* lds, const bf16_t* Qrow0, const AttnSeg s0, const AttnSeg s1, float Mb, float lam, const float* subg, bf16_t* Xrow0) {
    int tid = threadIdx.x; asm volatile("" : "+v"(tid));
    const int wid = tid >> 6, lane = tid & 63, qblk = wid >> 1, st = wid & 1, q = lane & 31, hi = lane >> 5;
    bf16x8 qf[4];
#pragma unroll
    for (int kk = 0; kk < 4; ++kk) qf[kk] = *(const bf16x8*)(Qrow0 + (size_t)(qblk * 32 + q) * 512 + st * 64 + kk * 16 + hi * 8);
    f32x16 oacc[4];
#pragma unroll
    for (int eb = 0; eb < 4; ++eb)
#pragma unroll
        for (int i = 0; i < 16; ++i) oacc[eb][i] = 0.f;
    float lsum = 0.f;
    const int nt = s0.ntiles + s1.ntiles;
    u32x4 kreg[4], vreg[4];
    const int kkey = tid >> 4, kpart = tid & 15;
    const int pir = (q & 0x13) | ((q & 4) << 1) | ((q & 8) >> 1);
#define AT_LOAD(t) do { const bool in0 = (t) < s0.ntiles; const int tl = in0 ? (t) : (t) - s0.ntiles; const bf16_t* Kp = (in0 ? s0.K : s1.K) + (size_t)tl * 128 * 512; \
        const bf16_t* Vp = (in0 ? s0.Vt : s1.Vt) + tl * 128; const int vs = in0 ? s0.vstride : s1.vstride; \
        _Pragma("unroll") for (int i_ = 0; i_ < 4; ++i_) { kreg[i_] = *(const u32x4*)(Kp + (size_t)(kkey + 32 * i_) * 512 + kpart * 8); vreg[i_] = *(const u32x4*)(Vp + (size_t)(kkey + 32 * i_) * vs + kpart * 8); } } while (0)
#define AT_STORE(buf) do { LAS unsigned char* kb_ = lds + AT_K0 + (buf) * AT_KB; LAS unsigned char* vb_ = lds + AT_V0 + (buf) * AT_VB; \
        _Pragma("unroll") for (int i_ = 0; i_ < 4; ++i_) { *(LAS u32x4*)(kb_ + (kkey + 32 * i_) * 272 + kpart * 16) = kreg[i_]; *(LAS u32x4*)(vb_ + (kkey + 32 * i_) * 272 + kpart * 16) = vreg[i_]; } } while (0)
    AT_LOAD(0); AT_STORE(0); __syncthreads();
    for (int t = 0; t < nt; ++t) {
        const int buf = t & 1;
        if (t + 1 < nt) AT_LOAD(t + 1);
#pragma unroll
        for (int sub = 0; sub < 2; ++sub) {
        const LAS unsigned char* kb = lds + AT_K0 + buf * AT_KB + sub * 64 * 272 + st * 128 + hi * 16;
        const LAS unsigned char* vb = lds + AT_V0 + buf * AT_VB + q * 272 + sub * 128 + hi * 16;
        f32x16 sacc[2];
#pragma unroll
        for (int k2 = 0; k2 < 2; ++k2) {
#pragma unroll
            for (int i = 0; i < 16; ++i) sacc[k2][i] = -Mb;
#pragma unroll
            for (int kk = 0; kk < 4; ++kk) { const bf16x8 a = *(const LAS bf16x8*)(kb + (k2 * 32 + pir) * 272 + kk * 32);
                sacc[k2] = __builtin_amdgcn_mfma_f32_32x32x16_bf16(a, qf[kk], sacc[k2], 0, 0, 0); }
        }
        bf16x8 pf[4];
#pragma unroll
        for (int k2 = 0; k2 < 2; ++k2) {
            float p[16];
#pragma unroll
            for (int i = 0; i < 16; ++i) { p[i] = __builtin_amdgcn_exp2f(sacc[k2][i]); lsum += p[i]; }
#pragma unroll
            for (int u = 0; u < 2; ++u) { u32x4 w; w.x = pk2(p[8 * u + 0], p[8 * u + 1]); w.y = pk2(p[8 * u + 2], p[8 * u + 3]); w.z = pk2(p[8 * u + 4], p[8 * u + 5]); w.w = pk2(p[8 * u + 6], p[8 * u + 7]);
                pf[2 * k2 + u] = __builtin_bit_cast(bf16x8, w); }
        }
#pragma unroll
        for (int eb = 0; eb < 4; ++eb)
#pragma unroll
            for (int kk = 0; kk < 4; ++kk) { const bf16x8 a = *(const LAS bf16x8*)(vb + eb * 32 * 272 + kk * 32);
                oacc[eb] = __builtin_amdgcn_mfma_f32_32x32x16_bf16(a, pf[kk], oacc[eb], 0, 0, 0); }
        }
        if (t + 1 < nt) AT_STORE(buf ^ 1);
        __syncthreads();
    }
#undef AT_LOAD
#undef AT_STORE
    const float l = lsum + __shfl_xor(lsum, 32);
    const float scale = (st == 0) ? 1.f / l : -lam / l;
    LAS float* Tq = (LAS float*)(lds + qblk * (32 * 129 * 4));
    if (st == 1) {
#pragma unroll
        for (int eb = 0; eb < 4; ++eb)
#pragma unroll
            for (int i = 0; i < 16; ++i) { const int e = eb * 32 + (i & 3) + 8 * (i >> 2) + 4 * hi; Tq[q * 129 + e] = oacc[eb][i] * scale; }
    }
    __syncthreads();
    if (st == 0) {
        float ss = 0.f;
#pragma unroll
        for (int eb = 0; eb < 4; ++eb)
#pragma unroll
            for (int i = 0; i < 16; ++i) { const int e = eb * 32 + (i & 3) + 8 * (i >> 2) + 4 * hi; const float v = oacc[eb][i] * scale + Tq[q * 129 + e]; oacc[eb][i] = v; ss += v * v; }
        ss += __shfl_xor(ss, 32);
        const float rstd = rsqrtf(ss * (1.f / 128.f) + EPS) * (1.f - LAM_INIT);
#pragma unroll
        for (int eb = 0; eb < 4; ++eb)
#pragma unroll
            for (int i = 0; i < 16; ++i) { const int e = eb * 32 + (i & 3) + 8 * (i >> 2) + 4 * hi; Tq[q * 129 + e] = oacc[eb][i] * rstd; }
    }
    __syncthreads();
    {
        const int l2 = st * 64 + lane;
        const f32x4 g0 = *(const f32x4*)(subg + (l2 & 15) * 8), g1 = *(const f32x4*)(subg + (l2 & 15) * 8 + 4);
#pragma unroll
        for (int it = 0; it < 4; ++it) { const int idx = it * 128 + l2, row = idx >> 4, c8 = (idx & 15) * 8; const LAS float* s = Tq + row * 129 + c8;
            u32x4 w; w.x = pk2(s[0] * g0.x, s[1] * g0.y); w.y = pk2(s[2] * g0.z, s[3] * g0.w); w.z = pk2(s[4] * g1.x, s[5] * g1.y); w.w = pk2(s[6] * g1.z, s[7] * g1.w);
            *(u32x4*)(Xrow0 + (size_t)(qblk * 32 + row) * D + c8) = w; }
    }
    __syncthreads();
}

#define XB_XCNT(j)  (256  + 64 * (j))
#define XB_XSUB(j)  (1280 + 64 * (j))
#define XB_XGEN(j)  (2304 + 64 * (j))
#define XB_TOP      3328
#define XB_TOPGEN   3392
#define XCD_BAR_WORDS 3456
__device__ __forceinline__ unsigned xb_ld(unsigned* p)              { return __hip_atomic_load(p, __ATOMIC_RELAXED, __HIP_MEMORY_SCOPE_AGENT); }
__device__ __forceinline__ unsigned xb_add(unsigned* p, unsigned v) { return __hip_atomic_fetch_add(p, v, __ATOMIC_RELAXED, __HIP_MEMORY_SCOPE_AGENT); }
__device__ __forceinline__ unsigned xb_xcc_id() { return (unsigned)__builtin_amdgcn_s_getreg((3 << 11) | 20) & 0xFu; }
__device__ __forceinline__ void grid_bar(unsigned* bar, volatile LAS unsigned* st) {
    asm volatile("s_waitcnt vmcnt(0) lgkmcnt(0)" ::: "memory");
    __syncthreads();
    if (threadIdx.x == 0) {
        const unsigned x = xb_xcc_id();
        unsigned nloc = st[0], nx = st[1];
        if (nloc == 0u) {
            const unsigned Gt = gridDim.x;
            for (;;) { unsigned sum = 0u, cnt = 0u, mine = 0u;
#pragma unroll
                for (unsigned j = 0; j < 16; ++j) { const unsigned c = xb_ld(&bar[XB_XCNT(j)]); sum += c; cnt += (c > 0u) ? 1u : 0u; mine = (j == x) ? c : mine; }
                if (sum == Gt) { nloc = mine; nx = cnt; break; }
                __builtin_amdgcn_s_sleep(1); }
            st[0] = nloc; st[1] = nx;
        }
        const unsigned old = xb_add(&bar[XB_XSUB(x)], 1u);
        const unsigned gen = old / nloc;
        if (old + 1u == (gen + 1u) * nloc) {
            __builtin_amdgcn_fence(__ATOMIC_RELEASE, "agent");
            asm volatile("s_waitcnt vmcnt(0)" ::: "memory");
            const unsigned og = xb_add(&bar[XB_TOP], 1u);
            const unsigned tg = og / nx;
            if (og + 1u == (tg + 1u) * nx) xb_add(&bar[XB_TOPGEN], 1u);
            else { while (xb_ld(&bar[XB_TOPGEN]) == tg) __builtin_amdgcn_s_sleep(1); }
            __builtin_amdgcn_fence(__ATOMIC_ACQUIRE, "agent");
            xb_add(&bar[XB_XGEN(x)], 1u);
            asm volatile("s_waitcnt vmcnt(0)" ::: "memory");
        } else {
            while (xb_ld(&bar[XB_XGEN(x)]) == gen) __builtin_amdgcn_s_sleep(1);
            __builtin_amdgcn_fence(__ATOMIC_ACQUIRE, "agent");
            asm volatile("s_waitcnt vmcnt(0)" ::: "memory");
        }
    }
    __syncthreads();
}

template <bool COOP>
__global__ void __launch_bounds__(512) fwd_kernel(Args A) {
    extern __shared__ __attribute__((aligned(16))) unsigned char lds_raw[];
    LAS unsigned char* lds = (LAS unsigned char*)lds_raw;
    const int tid = threadIdx.x, lane = tid & 63, wid = __builtin_amdgcn_readfirstlane(tid >> 6);
    const int G = gridDim.x, bx = blockIdx.x;
    const int gw = bx * 8 + wid, NGW = G * 8;
    unsigned char* ws = A.ws;
    float* mod = (float*)(ws + WS_MOD); float* bmax = (float*)(ws + WS_BMAX);
    bf16_t* WinT = (bf16_t*)(ws + WS_WIN); bf16_t* WoutT = (bf16_t*)(ws + WS_WOUT); bf16_t* W1T = (bf16_t*)(ws + WS_W1); bf16_t* W2T = (bf16_t*)(ws + WS_W2);
    bf16_t* Mt = (bf16_t*)(ws + WS_MT); bf16_t* DftC = (bf16_t*)(ws + WS_DFTC); bf16_t* DftL = (bf16_t*)(ws + WS_DFTL);
    bf16_t* Hb = (bf16_t*)(ws + WS_H); bf16_t* X2 = (bf16_t*)(ws + WS_X2); bf16_t* A2 = (bf16_t*)(ws + WS_A2); float* ssq = (float*)(ws + WS_SSQ); float* bias2 = (float*)(ws + WS_BIAS2);
    bf16_t* P = (bf16_t*)(ws + WS_P); bf16_t* Fpart = (bf16_t*)(ws + WS_FPART); bf16_t* Vt = (bf16_t*)(ws + WS_VT); bf16_t* U = (bf16_t*)(ws + WS_U);
    bf16_t* Kc = (bf16_t*)(ws + WS_KC); bf16_t* Vtc = (bf16_t*)(ws + WS_VTC); bf16_t* Qn = (bf16_t*)(ws + WS_QN); bf16_t* Kn = (bf16_t*)(ws + WS_KN);
    bf16_t* GtL = (bf16_t*)(ws + WS_GTL); bf16_t* GtC = (bf16_t*)(ws + WS_GTC);
    float* out_y = A.out; float* out_nck = A.out + (size_t)NTOK * D; float* out_ncv = out_nck + (size_t)NCTX * 512;
    const int lo = A.ph_lo, hi = A.ph_hi;
#define IN(k) (lo <= (k) && (k) < hi)
    unsigned* barw = (unsigned*)(ws + WS_BAR);
    volatile LAS unsigned* bst = (volatile LAS unsigned*)(lds + 139264);
    if (COOP && A.ph_lo < 0) cg::this_grid().sync();
    if (COOP) { if (tid == 0) { bst[0] = 0u; bst[1] = 0u; (void)xb_add(&barw[XB_XCNT(xb_xcc_id())], 1u); } __syncthreads(); }
#define SEAM(k) do { if (COOP && IN(k) && IN((k) + 1)) { for (int rb = 0; rb < NREP(13); ++rb) grid_bar(barw, bst); } } while (0)

    for (int rep = 0; rep < NREP(0); ++rep) if (IN(0)) {
        LAS float* tab = (LAS float*)(lds);
        LAS float* scs = (LAS float*)(lds + 8192);
        LAS float* red = (LAS float*)(lds + 8192 + 20480);
        LAS float* scr = (LAS float*)(lds + 40960 + wid * 8448);
        for (int i = tid; i < 2048; i += 512) tab[i] = cospif((float)i * (1.f / 1024.f));
        {   float cv[10];
#pragma unroll
            for (int j = 0; j < 10; ++j) { const int i = tid + 512 * j, mi = i >> 10, k = i & 1023; const float* src = (mi == 0) ? A.c_ctx + k : A.c + (mi - 1) * 1024 + k; cv[j] = *src; }
#pragma unroll
            for (int j = 0; j < 10; ++j) scs[tid + 512 * j] = cv[j] / (1.f + __expf(-cv[j])); }
        __syncthreads();
        for (int rp = 0; rp < NREP(14); ++rp)
        for (int item = bx; item < 192; item += G) {
            const int cl = tid & 31, kg = tid >> 5, col = item * 32 + cl, kb = kg * 64; float a0 = 0.f, a1 = 0.f, a2 = 0.f, a3 = 0.f, a4 = 0.f;
            float wv[64];
#pragma unroll
            for (int k = 0; k < 64; ++k) wv[k] = __builtin_nontemporal_load(A.w_mod + (size_t)(kb + k) * 6144 + col);
#pragma unroll
            for (int k = 0; k < 64; ++k) { const float w = wv[k]; const int kk = kb + k;
                a0 += scs[kk] * w; a1 += scs[1024 + kk] * w; a2 += scs[2048 + kk] * w; a3 += scs[3072 + kk] * w; a4 += scs[4096 + kk] * w; }
            red[(kg * 5 + 0) * 32 + cl] = a0; red[(kg * 5 + 1) * 32 + cl] = a1; red[(kg * 5 + 2) * 32 + cl] = a2; red[(kg * 5 + 3) * 32 + cl] = a3; red[(kg * 5 + 4) * 32 + cl] = a4;
            __syncthreads();
            if (tid < 160) { const int mi = tid >> 5; float s_ = A.b_mod[item * 32 + cl];
#pragma unroll
                for (int w = 0; w < 16; ++w) s_ += red[(w * 5 + mi) * 32 + cl];
                mod[(size_t)mi * 6144 + item * 32 + cl] = s_; }
            __syncthreads();
        }
        for (int rp = 0; rp < NREP(15); ++rp) {
        for (int rr = bx; rr < 1024; rr += G) { const int r = rr * 2 + (tid >> 8), sn_ = r >> 10, n = r & 1023, n0 = (tid & 255) * 8; float v[8];
            const int idx0 = (n * n0) & 2047; float c_ = tab[idx0], s_ = tab[(idx0 - 512) & 2047]; const float c1 = tab[n], s1 = tab[(n - 512) & 2047];
#pragma unroll
            for (int j = 0; j < 8; ++j) { v[j] = (sn_ ? s_ : c_) * 0.02209708691207961f; const float cn = c_ * c1 - s_ * s1; s_ = s_ * c1 + c_ * s1; c_ = cn; }
            u32x4 w; w.x = pk2(v[0], v[1]); w.y = pk2(v[2], v[3]); w.z = pk2(v[4], v[5]); w.w = pk2(v[6], v[7]);
            *(u32x4*)(DftL + (size_t)r * 2048 + n0) = w; }
        for (int ch = bx * 512 + tid; ch < 16384; ch += G * 512) { const int r = ch >> 6, c0 = (ch & 63) * 8, cs = c0 >> 8, n0 = c0 & 255; float v[8];
#pragma unroll
            for (int j = 0; j < 8; ++j) { const int idx = ((r * (n0 + j)) & 255) * 8; v[j] = (cs ? -tab[(idx - 512) & 2047] : tab[idx]) * 0.0625f; }
            u32x4 w; w.x = pk2(v[0], v[1]); w.y = pk2(v[2], v[3]); w.z = pk2(v[4], v[5]); w.w = pk2(v[6], v[7]);
            *(u32x4*)(DftC + (size_t)r * 512 + c0) = w; }
        {   LAS float* wl = red;
            LAS float* Tt = (LAS float*)(lds + 40960);
            for (int blk = bx; blk < 256; blk += G) { const int combo = blk >> 5, g = combo >> 1, cs = combo & 1, e0 = (blk & 31) * 4;
                __syncthreads();
                wl[tid] = A.w_four[(size_t)g * 16384 + (tid >> 2) * 128 + e0 + (tid & 3)];
                for (int i = tid; i < 16384; i += 512) { const float a_ = (float)(((i & 127) * (i >> 7)) & 127) * (1.f / 64.f); Tt[i] = cs ? sinpif(a_) : cospif(a_); }
                __syncthreads();
                const int el = tid >> 7, c = tid & 127; float s_ = 0.f;
#pragma unroll 8
                for (int ep = 0; ep < 128; ++ep) s_ += Tt[ep * 128 + c] * wl[ep * 4 + el];
                Mt[(size_t)g * 32768 + (size_t)(cs * 128 + e0 + el) * 128 + c] = (bf16_t)(pk2(s_ * 0.08838834764831845f, 0.f) & 0xffffu); }
            __syncthreads();
        }
        }
        float kmax = 0.f;
        constexpr int I_IN = 16 * 64, I_OUT = 16 * 32, I_1 = 16 * 128, I_2 = 64 * 32, I_CV = 4 * 128, I_CK = 4 * PAST;
        constexpr int NITEMS = I_IN + I_OUT + I_1 + I_2 + I_CV + I_CK;
        constexpr int NTR = I_IN + I_OUT + I_1 + I_2 + I_CV;
#define TR_DESC(it_, t_) do { int r_ = (it_); \
            if (r_ < I_IN) { t_.W = A.w_in; t_.WT = WinT; t_.K = D; t_.N = 2048; t_.item = r_; } else { r_ -= I_IN; \
            if (r_ < I_OUT) { t_.W = A.w_out; t_.WT = WoutT; t_.K = D; t_.N = D; t_.item = r_; } else { r_ -= I_OUT; \
            if (r_ < I_1) { t_.W = A.w1; t_.WT = W1T; t_.K = D; t_.N = DFF; t_.item = r_; } else { r_ -= I_1; \
            if (r_ < I_2) { t_.W = A.w2; t_.WT = W2T; t_.K = DFF; t_.N = D; t_.item = r_; } else { r_ -= I_2; \
            const int b_ = r_ >> 7; t_.W = A.cache_v + (size_t)b_ * 512 * 512; t_.WT = Vtc + (size_t)b_ * 512 * 512; t_.K = 512; t_.N = 512; t_.item = r_ & 127; } } } } } while (0)
        for (int rp = 0; rp < NREP(16); ++rp) {
        {   TrItem cur, nxt; f32x4 va[8], vb[8]; int it = gw;
            if (it < NTR) { TR_DESC(it, cur); transpose_load(cur, va, lane); }
            while (it < NTR) {
                const int itn = it + NGW; const bool hn = itn < NTR;
                if (hn) { TR_DESC(itn, nxt); transpose_load(nxt, vb, lane); }
                transpose_store(cur, va, scr, lane);
                if (hn) { cur = nxt;
#pragma unroll
                    for (int i = 0; i < 8; ++i) va[i] = vb[i]; }
                it = itn;
            }
        }
#undef TR_DESC
        for (int r = gw; r < I_CK; r += NGW) {
            const float* src = A.cache_k + (size_t)r * 512 + lane * 8; const f32x4 v0 = __builtin_nontemporal_load((const f32x4*)src), v1 = __builtin_nontemporal_load((const f32x4*)(src + 4));
            float ss = (v0.x * v0.x + v0.y * v0.y) + (v0.z * v0.z + v0.w * v0.w) + (v1.x * v1.x + v1.y * v1.y) + (v1.z * v1.z + v1.w * v1.w);
            ss += __shfl_xor(ss, 1); ss += __shfl_xor(ss, 2); ss += __shfl_xor(ss, 4); kmax = fmaxf(kmax, ss);
            *(u32x4*)(Kc + (size_t)r * 512 + lane * 8) = pack8(v0, v1); }
        }
        kmax = wave_max(kmax);
        __syncthreads();
        if (lane == 0) red[wid] = kmax;
        __syncthreads();
        if (tid == 0) { float m = 0.f; for (int w = 0; w < 8; ++w) m = fmaxf(m, red[w]); bmax[bx] = m; }
        __syncthreads();
    }
    SEAM(0);
    for (int rep = 0; rep < NREP(1); ++rep) if (IN(1)) {
        rowpass_h(A.x_prompt, A.x_sample, A.norm1_g, mod, 0, 1024, Hb, gw, NGW, lane);
        int l3 = threadIdx.x & 63; asm volatile("" : "+v"(l3));
        {
            f32x4 shv[5][4];
#pragma unroll
            for (int mi = 0; mi < 5; ++mi)
#pragma unroll
                for (int j = 0; j < 4; ++j) shv[mi][j] = *(const f32x4*)(mod + (size_t)mi * 6144 + 3072 + l3 * 16 + 4 * j);
            for (int col = gw; col < DFF; col += NGW) {
                const bf16_t* wr_ = W1T + (size_t)col * D + l3 * 16; const u32x4 w0 = *(const u32x4*)wr_, w1 = *(const u32x4*)(wr_ + 8);
                float w[16];
                w[0] = bflo(w0.x); w[1] = bfhi(w0.x); w[2] = bflo(w0.y); w[3] = bfhi(w0.y); w[4] = bflo(w0.z); w[5] = bfhi(w0.z); w[6] = bflo(w0.w); w[7] = bfhi(w0.w);
                w[8] = bflo(w1.x); w[9] = bfhi(w1.x); w[10] = bflo(w1.y); w[11] = bfhi(w1.y); w[12] = bflo(w1.z); w[13] = bfhi(w1.z); w[14] = bflo(w1.w); w[15] = bfhi(w1.w);
                float r5[5];
#pragma unroll
                for (int mi = 0; mi < 5; ++mi) { float sacc = 0.f;
#pragma unroll
                    for (int j = 0; j < 4; ++j) sacc += (w[4 * j] * shv[mi][j].x + w[4 * j + 1] * shv[mi][j].y) + (w[4 * j + 2] * shv[mi][j].z + w[4 * j + 3] * shv[mi][j].w);
                    r5[mi] = wave_sum(sacc); }
                if (l3 < 5) bias2[(size_t)l3 * DFF + col] = (l3 == 0) ? r5[0] : (l3 == 1) ? r5[1] : (l3 == 2) ? r5[2] : (l3 == 3) ? r5[3] : r5[4];
            }
        }
    }
    SEAM(1);
    for (int rep = 0; rep < NREP(2); ++rep) if (IN(2)) {
        {   pg8::Gemm g{D, D, D}; SchedInproj S{(const char*)Hb, (const char*)WinT, G, bx};
            EpiInproj E{P, Vt, out_ncv, Qn, Kn, out_nck, A.q_norm_g, A.k_norm_g, (LAS float*)(lds + 131072)};
            pg8::gemm_phase(lds, g, S, E); }
        {   pg8::Gemm g{128, 512, 128}; SchedFourChain S{(const char*)Mt, (const char*)P, G, bx}; EpiFourLocal E{GtC, GtL};
            pg8::gemm_phase(lds, g, S, E); }
    }
    SEAM(2);
    for (int rep = 0; rep < NREP(3); ++rep) if (IN(3)) {
        for (int rep2 = 0; rep2 < NREP(11); ++rep2)
        {   pg8::Gemm g{2048, 4096, 512}; SchedPosL S{(const char*)DftL, (const char*)GtL, G, bx}; EpiPlain<0> E{Fpart, 2048};
            pg8::gemm_phase(lds, g, S, E); }
        for (int rep2 = 0; rep2 < NREP(12); ++rep2)
        {   pg8::Gemm g{512, 512, 512}; SchedPosC S{(const char*)DftC, (const char*)GtC, G, bx}; EpiPlain<0> E{X2, D};
            pg8::gemm_phase(lds, g, S, E); }
        int l4 = threadIdx.x & 63; asm volatile("" : "+v"(l4));
        const float d1 = wave_sum(A.lq1[l4] * A.lk1[l4]), d2 = wave_sum(A.lq2[l4] * A.lk2[l4]);
        const float gqm = wave_max(fabsf(A.q_norm_g[l4])), gkm = wave_max(fabsf(A.k_norm_g[l4]));
        const float lam = __expf(d1) - __expf(d2) + LAM_INIT;
        float cm = 0.f; for (int i = l4; i < G; i += 64) cm = fmaxf(cm, bmax[i]); cm = wave_max(cm);
        const float qn = 8.f * gqm * QSCALE * 1.01f, knl = 8.f * gkm * 1.01f;
        const float Mb_ctx = qn * knl, Mb_lat = qn * fmaxf(knl, sqrtf(cm) * 1.01f);
        for (int rep2 = 0; rep2 < NREP(10); ++rep2)
        for (int u = bx; u < 512; u += G) {
            const bool lat = u < 256; const int v = u & 255;
            const int b = lat ? (v >> 6) : (v >> 3), h = lat ? ((v >> 4) & 3) : ((v >> 1) & 3), qb = lat ? (v & 15) : (v & 1);
            const size_t tok0 = lat ? (size_t)NCTX + b * LSEQ : (size_t)b * CSEQ;
            AttnSeg s0, s1;
            s1.K = Kn + tok0 * 512 + h * 128; s1.Vt = Vt + (size_t)h * 128 * NTOK + tok0; s1.vstride = NTOK; s1.ntiles = lat ? LSEQ / 128 : CSEQ / 128;
            s0.K = Kc + (size_t)b * PAST * 512 + h * 128; s0.Vt = Vtc + ((size_t)b * 512 + h * 128) * 512; s0.vstride = 512; s0.ntiles = lat ? PAST / 128 : 0;
            if (!lat) { s0.K = s1.K; s0.Vt = s1.Vt; s0.vstride = NTOK; }
            attn_unit(lds, Qn + (tok0 + qb * 128) * 512 + h * 128, s0, s1, lat ? Mb_lat : Mb_ctx, lam, A.subln_g, X2 + (tok0 + qb * 128) * D + h * 128);
        }
    }
    SEAM(3);
    for (int rep = 0; rep < NREP(4); ++rep) if (IN(4)) {
        for (int idx = bx * 512 + tid; idx < 1024 * 256; idx += G * 512) { const int n = idx >> 8, c8 = (idx & 255) * 8, b = c8 >> 9, ge = c8 & 511;
            float pc[8] = {0.f, 0.f, 0.f, 0.f, 0.f, 0.f, 0.f, 0.f}, ps[8] = {0.f, 0.f, 0.f, 0.f, 0.f, 0.f, 0.f, 0.f};
#pragma unroll
            for (int z = 0; z < 4; ++z) { const u32x4 w = __builtin_nontemporal_load((const u32x4*)(Fpart + (size_t)z * 2048 * 2048 + (size_t)n * 2048 + c8)), y = __builtin_nontemporal_load((const u32x4*)(Fpart + (size_t)z * 2048 * 2048 + (size_t)(1024 + n) * 2048 + c8));
                pc[0] += bflo(w.x); pc[1] += bfhi(w.x); pc[2] += bflo(w.y); pc[3] += bfhi(w.y); pc[4] += bflo(w.z); pc[5] += bfhi(w.z); pc[6] += bflo(w.w); pc[7] += bfhi(w.w);
                ps[0] += bflo(y.x); ps[1] += bfhi(y.x); ps[2] += bflo(y.y); ps[3] += bfhi(y.y); ps[4] += bflo(y.z); ps[5] += bfhi(y.z); ps[6] += bflo(y.w); ps[7] += bfhi(y.w); }
            u32x4 o; o.x = pk2(pc[0] - ps[0], pc[1] - ps[1]); o.y = pk2(pc[2] - ps[2], pc[3] - ps[3]); o.z = pk2(pc[4] - ps[4], pc[5] - ps[5]); o.w = pk2(pc[6] - ps[6], pc[7] - ps[7]);
            *(u32x4*)(X2 + ((size_t)NCTX + b * LSEQ + n) * D + 512 + ge) = o;
            if (n >= 1) { u32x4 p; p.x = pk2(pc[0] + ps[0], pc[1] + ps[1]); p.y = pk2(pc[2] + ps[2], pc[3] + ps[3]); p.z = pk2(pc[4] + ps[4], pc[5] + ps[5]); p.w = pk2(pc[6] + ps[6], pc[7] + ps[7]);
                *(u32x4*)(X2 + ((size_t)NCTX + b * LSEQ + (LSEQ - n)) * D + 512 + ge) = p; } }
        for (int col = gw; col < 2048; col += NGW) { const bf16_t* gr = GtL + (size_t)col * 4096 + lane * 32; float sacc = 0.f;
#pragma unroll
            for (int j = 0; j < 4; ++j) { const u32x4 w = *(const u32x4*)(gr + 8 * j);
                sacc += (bflo(w.x) - bfhi(w.x)) + (bflo(w.y) - bfhi(w.y)) + (bflo(w.z) - bfhi(w.z)) + (bflo(w.w) - bfhi(w.w)); }
            sacc = wave_sum(sacc) * 0.02209708691207961f;
            if (lane == 0) X2[((size_t)NCTX + (col >> 9) * LSEQ + 1024) * D + 512 + (col & 511)] = (bf16_t)(pk2(sacc, 0.f) & 0xffffu); }
    }
    SEAM(4);
    for (int rep = 0; rep < NREP(5); ++rep) if (IN(5)) {
        pg8::Gemm g{D, D, D}; SchedStd S{(const char*)X2, (const char*)WoutT, 64, 4, (size_t)256 * D * 2, (size_t)256 * D * 2, D, G, bx};
        EpiOut E{A.x_prompt, A.x_sample, mod, A.norm2_g, out_y, A2, ssq};
        pg8::gemm_phase(lds, g, S, E);
    }
    SEAM(5);
    for (int rep = 0; rep < NREP(6); ++rep) if (IN(6)) {
        pg8::Gemm g{D, D, D}; SchedStd S{(const char*)A2, (const char*)W1T, 64, 16, (size_t)256 * D * 2, (size_t)256 * D * 2, DFF, G, bx};
        EpiUp E{U, ssq, bias2};
        pg8::gemm_phase(lds, g, S, E);
    }
    SEAM(6);
    for (int rep = 0; rep < NREP(7); ++rep) if (IN(7)) {
        pg8::Gemm g{DFF, DFF, DFF}; SchedStd S{(const char*)U, (const char*)W2T, 64, 4, (size_t)256 * DFF * 2, (size_t)256 * DFF * 2, D, G, bx};
        EpiResid E{out_y, out_y + (size_t)NCTX * D, mod + 5120, out_y};
        pg8::gemm_phase(lds, g, S, E);
    }
#undef IN
#undef SEAM
}

extern "C" void kernel_launch(void* const* d_in, const int* in_sizes, int n_in, void* d_out, int out_size, void* d_ws, size_t ws_size, hipStream_t stream) {
    static int grid = 0;
    if (grid == 0) {
        if (n_in != 22 || ws_size < WS_END) { fprintf(stderr, "kernel_launch: need 22 inputs and >= %zu bytes of workspace; got %d, %zu\n", (size_t)WS_END, n_in, ws_size); grid = -1; return; }
        int dev = 0, cus = 0, per_cu = 0;
        hipGetDevice(&dev); hipDeviceGetAttribute(&cus, hipDeviceAttributeMultiprocessorCount, dev);
        hipFuncSetAttribute((const void*)fwd_kernel<true>, hipFuncAttributeMaxDynamicSharedMemorySize, LDS_BYTES);
        hipFuncSetAttribute((const void*)fwd_kernel<false>, hipFuncAttributeMaxDynamicSharedMemorySize, LDS_BYTES);
        hipOccupancyMaxActiveBlocksPerMultiprocessor(&per_cu, (const void*)fwd_kernel<true>, 512, LDS_BYTES);
        if (per_cu < 1) { fprintf(stderr, "kernel_launch: occupancy query says %d blocks per CU\n", per_cu); per_cu = 1; }
        (void)hipGetLastError();
        grid = cus * (per_cu > 1 ? 1 : per_cu);
        if (grid > 256) grid = 256;
    }
    if (grid < 0) return;
    Args a{};
    const float** f = (const float**)&a;
    for (int i = 0; i < 22; ++i) f[i] = (const float*)d_in[i];
    a.out = (float*)d_out; a.ws = (unsigned char*)d_ws;
#if ONE_LAUNCH
    hipMemsetAsync((char*)d_ws + WS_BAR, 0, 16384, stream);
    a.ph_lo = 0; a.ph_hi = NPH;
    void* args[] = {&a};
    hipError_t e = hipLaunchCooperativeKernel((const void*)fwd_kernel<true>, dim3(grid), dim3(512), args, LDS_BYTES, stream);
    if (e != hipSuccess) fprintf(stderr, "cooperative launch failed: %s (grid %d)\n", hipGetErrorString(e), grid);
#else
    for (int p = 0; p < NPH; ++p) { a.ph_lo = p; a.ph_hi = p + 1; hipLaunchKernelGGL(fwd_kernel<false>, dim3(grid), dim3(512), LDS_BYTES, stream, a); }
#endif
}
```

```cpp
#include <hip/hip_runtime.h>
#include <hip/hip_cooperative_groups.h>
#include <cstdio>
#include <cstdint>
namespace cg = cooperative_groups;

#define LAS __attribute__((address_space(3)))
typedef unsigned short bf16_t;
typedef short bf16x8 __attribute__((ext_vector_type(8)));
typedef float f32x4 __attribute__((ext_vector_type(4)));
typedef float f32x16 __attribute__((ext_vector_type(16)));
typedef unsigned u32x4 __attribute__((ext_vector_type(4)));
typedef unsigned u32x2 __attribute__((ext_vector_type(2)));

#ifndef REPMASK
#define REPMASK 0
#endif
#define NREP(k) (1 + ((REPMASK >> (k)) & 1))
#ifndef ONE_LAUNCH
#define ONE_LAUNCH 1
#endif

constexpr int D = 1024, NTOK = 16384, NCTX = 8192, LSEQ = 2048, CSEQ = 256, PAST = 512, DFF = 4096, PW = 1536  ;
constexpr int NPH = 8;
constexpr float EPS = 1e-6f;
constexpr float QSCALE = 0.125f * 1.4426950408889634f;
constexpr float LAM_INIT = 0.2f;

constexpr size_t MiB = 1u << 20;
constexpr size_t WS_MOD = 0;
constexpr size_t WS_BAR = 256 * 1024;
constexpr size_t WS_BMAX = 512 * 1024;
constexpr size_t WS_BIAS2 = 640 * 1024;
constexpr size_t WS_WIN = 1 * MiB, WS_WOUT = 5 * MiB, WS_W1 = 7 * MiB, WS_W2 = 15 * MiB, WS_MT = 23 * MiB, WS_DFTC = 24 * MiB;
constexpr size_t WS_H = 25 * MiB;
constexpr size_t WS_X2 = WS_H;
constexpr size_t WS_A2 = 57 * MiB;
constexpr size_t WS_P = 57 * MiB;
constexpr size_t WS_FPART = 57 * MiB;
constexpr size_t WS_VT = 105 * MiB;
constexpr size_t WS_U = 121 * MiB;
constexpr size_t WS_DFTL = 121 * MiB;
constexpr size_t WS_KC = 137 * MiB, WS_VTC = 139 * MiB;
constexpr size_t WS_QN = 141 * MiB, WS_KN = 157 * MiB;
constexpr size_t WS_GTL = 173 * MiB;
constexpr size_t WS_GTC = 189 * MiB;
constexpr size_t WS_SSQ = 249 * MiB;
constexpr size_t WS_END = 250 * MiB;

constexpr int LDS_BYTES = 147456;

__device__ __forceinline__ unsigned pk2(float lo, float hi) {
    typedef __bf16 bf2 __attribute__((ext_vector_type(2))); typedef float f2 __attribute__((ext_vector_type(2)));
    f2 v = {lo, hi}; return __builtin_bit_cast(unsigned, __builtin_convertvector(v, bf2));
}
__device__ __forceinline__ float bflo(unsigned w) { return __builtin_bit_cast(float, w << 16); }
__device__ __forceinline__ float bfhi(unsigned w) { return __builtin_bit_cast(float, w & 0xffff0000u); }
__device__ __forceinline__ float wave_sum(float v) {
#pragma unroll
    for (int o = 1; o < 64; o <<= 1) v += __shfl_xor(v, o);
    return v;
}
__device__ __forceinline__ float wave_max(float v) {
#pragma unroll
    for (int o = 1; o < 64; o <<= 1) v = fmaxf(v, __shfl_xor(v, o));
    return v;
}
#define LDS_WAIT() asm volatile("s_waitcnt lgkmcnt(0)" ::: "memory")

namespace pg8 {
constexpr int BM = 256, BK = 64, HALF = 128, HTB = HALF * BK * 2, STAGE_BYTES = 8 * HTB, NXCD = 8, WGM = 8;
__host__ __device__ __forceinline__ int lds_byte(int r, int c) { const int st = (r >> 4) * 2 + (c >> 5), rr = r & 15, cc = c & 31, ob = rr * 64 + cc * 2; return st * 1024 + (ob ^ (((ob >> 9) & 1) << 5)); }
__host__ __device__ __forceinline__ void stage_rc(int b, int& R, int& C) { const int st = b / 1024, sb = b % 1024, swz = sb ^ (((sb >> 9) & 1) << 5); R = (st >> 1) * 16 + swz / 64; C = (st & 1) * 32 + (swz % 64) / 2; }
__host__ __device__ __forceinline__ int perm32(int rho) { const int n = rho >> 4, i = rho & 15; return 8 * (i >> 2) + 4 * n + (i & 3); }

struct Unit { int pm, pn, z, pad; const char* a; const char* b; size_t coff; };
struct Gemm { int lda, ldb, K; };

__device__ __forceinline__ void tile_order(int L, int nM, int nN, int& pm, int& pn) {
    const int nwg = nM * nN; int wgid = L;
    { const int q = nwg / NXCD, r = nwg % NXCD, xcd = wgid % NXCD, off = wgid / NXCD; wgid = (xcd < r ? xcd * (q + 1) : r * (q + 1) + (xcd - r) * q) + off; }
    const int nig = WGM * nN, gid = wgid / nig, fm = gid * WGM, gsz = (nM - fm) < WGM ? (nM - fm) : WGM;
    pm = fm + ((wgid % nig) % gsz); pn = (wgid % nig) / gsz;
}

template <class Epi, class Sched>
__device__ __forceinline__ void gemm_phase(LAS unsigned char* lds, const Gemm g, const Sched& S, const Epi& E) {
    int tid = threadIdx.x; asm volatile("" : "+v"(tid));
    const int wid = __builtin_amdgcn_readfirstlane(tid >> 6), lane = tid & 63, wr = wid >> 2, wc = wid & 3, fr = lane & 15, fq = lane >> 4;
    int K = g.K; asm volatile("" : "+s"(K)); const int nt = K / BK;
    unsigned voffA[2], voffB[2];
#pragma unroll
    for (int i = 0; i < 2; ++i) { int R, C; stage_rc(tid * 16 + i * 8192, R, C); const int Rb = (R & ~31) + perm32(R & 31);
        voffA[i] = (unsigned)(R * g.lda + C) * 2u; voffB[i] = (unsigned)(Rb * g.ldb + C) * 2u; }
    const size_t kstep = (size_t)(BK * 2);
    const size_t hA = (size_t)HALF * g.lda * 2, hB = (size_t)HALF * g.ldb * 2;
    const unsigned ldsw = (unsigned)wid * 1024u;
    const int aoff = lds_byte(wr * 64 + fr, fq * 8), boff = lds_byte(wc * 32 + fr, fq * 8);
#define PG8_SA(b, h) (((b) * 2 + (h)) * HTB)
#define PG8_SB(b, h) ((4 + (b) * 2 + (h)) * HTB)
#define PG8_STAGE(bufoff, gbase, voff) do { _Pragma("unroll") for (int _i = 0; _i < 2; ++_i) \
        __builtin_amdgcn_global_load_lds((const unsigned*)((const char*)(gbase) + (voff)[_i]), (LAS unsigned*)(lds + (bufoff) + ldsw + _i * 8192), 16, 0, 0); } while (0)
#define PG8_LDA(dst, b, h) do { _Pragma("unroll") for (int m = 0; m < 4; ++m) _Pragma("unroll") for (int k = 0; k < 2; ++k) dst[m][k] = *(const LAS bf16x8*)(lds + PG8_SA(b, h) + aoff + m * 2048 + k * 1024); } while (0)
#define PG8_LDB(dst, b, h) do { _Pragma("unroll") for (int n = 0; n < 2; ++n) _Pragma("unroll") for (int k = 0; k < 2; ++k) dst[n][k] = *(const LAS bf16x8*)(lds + PG8_SB(b, h) + boff + n * 2048 + k * 1024); } while (0)
#define PG8_MMA(ai, bj, At, Bt) do { __builtin_amdgcn_s_setprio(1); _Pragma("unroll") for (int m = 0; m < 4; ++m) _Pragma("unroll") for (int n = 0; n < 2; ++n) _Pragma("unroll") for (int k = 0; k < 2; ++k) \
        acc[ai][bj][m][n] = __builtin_amdgcn_mfma_f32_16x16x32_bf16(Bt[n][k], At[m][k], acc[ai][bj][m][n], 0, 0, 0); __builtin_amdgcn_s_setprio(0); } while (0)
#define PG8_WAIT_V(n) asm volatile("s_waitcnt vmcnt(" #n ")" ::: "memory")
#define PG8_WAIT_L(n) asm volatile("s_waitcnt lgkmcnt(" #n ")" ::: "memory")
#define PG8_BAR __builtin_amdgcn_s_barrier()
#define PG8_SCHED __builtin_amdgcn_sched_barrier(0)
    Unit cur, nxt; int ui = 0;
    if (!S.next(0, cur)) return;
    f32x4 acc[2][2][4][2];
#pragma unroll
    for (int a = 0; a < 2; ++a)
#pragma unroll
        for (int b = 0; b < 2; ++b)
#pragma unroll
            for (int m = 0; m < 4; ++m)
#pragma unroll
                for (int n = 0; n < 2; ++n) acc[a][b][m][n] = (f32x4){0.f, 0.f, 0.f, 0.f};
    bf16x8 At[4][2], B0[2][2], B1[2][2];
    const char* cA = cur.a; const char* cB = cur.b;
    PG8_STAGE(PG8_SB(0, 0), cB, voffB); PG8_STAGE(PG8_SB(0, 1), cB + hB, voffB); PG8_STAGE(PG8_SA(0, 0), cA, voffA); PG8_STAGE(PG8_SA(0, 1), cA + hA, voffA);
    if (wr == 1) PG8_BAR;
    PG8_WAIT_V(2); PG8_BAR;
    PG8_STAGE(PG8_SB(1, 0), cB + kstep, voffB); PG8_STAGE(PG8_SA(1, 0), cA + kstep, voffA); PG8_STAGE(PG8_SB(1, 1), cB + hB + kstep, voffB);
    PG8_WAIT_V(6); PG8_BAR;
    for (;;) {
        const bool has_next = S.next(ui + 1, nxt);
        const char* nA = has_next ? nxt.a : cA; const char* nB = has_next ? nxt.b : cB;
        for (int t = 0; t < nt; t += 2) {
            const bool last = (t == nt - 2);
            const char* a1 = cA + (size_t)(t + 1) * kstep;
            const char* a2 = last ? nA : cA + (size_t)(t + 2) * kstep; const char* b2 = last ? nB : cB + (size_t)(t + 2) * kstep;
            const char* a3 = a2 + kstep; const char* b3 = b2 + kstep;
            PG8_LDB(B0, 0, 0); PG8_LDB(B1, 0, 1); PG8_SCHED; PG8_LDA(At, 0, 0); PG8_STAGE(PG8_SA(1, 1), a1 + hA, voffA);
            PG8_WAIT_V(8); PG8_WAIT_L(0); PG8_BAR; PG8_MMA(0, 0, At, B0); PG8_MMA(0, 1, At, B1); PG8_BAR; PG8_SCHED;
            PG8_LDA(At, 0, 1); PG8_STAGE(PG8_SB(0, 0), b2, voffB); PG8_STAGE(PG8_SB(0, 1), b2 + hB, voffB); PG8_STAGE(PG8_SA(0, 0), a2, voffA);
            PG8_WAIT_V(8); PG8_WAIT_L(0); PG8_BAR; PG8_MMA(1, 0, At, B0); PG8_MMA(1, 1, At, B1); PG8_BAR; PG8_SCHED;
            PG8_LDB(B0, 1, 0); PG8_LDB(B1, 1, 1); PG8_SCHED; PG8_LDA(At, 1, 0); PG8_STAGE(PG8_SA(0, 1), a2 + hA, voffA);
            PG8_WAIT_V(8); PG8_WAIT_L(0); PG8_BAR; PG8_MMA(0, 0, At, B0); PG8_MMA(0, 1, At, B1); PG8_BAR; PG8_SCHED;
            PG8_LDA(At, 1, 1); PG8_STAGE(PG8_SB(1, 0), b3, voffB); PG8_STAGE(PG8_SB(1, 1), b3 + hB, voffB); PG8_STAGE(PG8_SA(1, 0), a3, voffA);
            PG8_WAIT_V(8); PG8_WAIT_L(0); PG8_BAR; PG8_MMA(1, 0, At, B0); PG8_MMA(1, 1, At, B1); PG8_BAR; PG8_SCHED;
        }
        if (wr == 0) PG8_BAR;
        E(acc, cur, wr, wc, fr, fq);
        if (!has_next) break;
#pragma unroll
        for (int a = 0; a < 2; ++a)
#pragma unroll
            for (int b = 0; b < 2; ++b)
#pragma unroll
                for (int m = 0; m < 4; ++m)
#pragma unroll
                    for (int n = 0; n < 2; ++n) acc[a][b][m][n] = (f32x4){0.f, 0.f, 0.f, 0.f};
        cur = nxt; cA = nA; cB = nB; ++ui;
        if (wr == 1) PG8_BAR;
    }
    PG8_WAIT_V(0);
    PG8_BAR;
#undef PG8_SA
#undef PG8_SB
#undef PG8_STAGE
#undef PG8_LDA
#undef PG8_LDB
#undef PG8_MMA
#undef PG8_WAIT_V
#undef PG8_WAIT_L
#undef PG8_BAR
#undef PG8_SCHED
}
}
using pg8::Unit;

__device__ __forceinline__ u32x4 pack8(const f32x4 v0, const f32x4 v1) { u32x4 w; w.x = pk2(v0[0], v0[1]); w.y = pk2(v0[2], v0[3]); w.z = pk2(v1[0], v1[1]); w.w = pk2(v1[2], v1[3]); return w; }

template <int ACT> struct EpiPlain {
    bf16_t* O; int ldc;
    __device__ __forceinline__ void operator()(const f32x4 (&acc)[2][2][4][2], const Unit& u, int wr, int wc, int fr, int fq) const {
        bf16_t* base = O + u.coff + (size_t)(wr * 64 + fr) * ldc + wc * 32 + 8 * fq;
#pragma unroll
        for (int ai = 0; ai < 2; ++ai)
#pragma unroll
            for (int m = 0; m < 4; ++m) { bf16_t* rowp = base + (size_t)(ai * 128 + m * 16) * ldc;
#pragma unroll
                for (int bj = 0; bj < 2; ++bj) { f32x4 v0 = acc[ai][bj][m][0], v1 = acc[ai][bj][m][1];
                    if (ACT == 1) {
#pragma unroll
                        for (int j = 0; j < 4; ++j) { const float a = fmaxf(v0[j], 0.f), b = fmaxf(v1[j], 0.f); v0[j] = a * a; v1[j] = b * b; } }
                    *(u32x4*)(rowp + bj * 128) = pack8(v0, v1); } }
    }
};

struct EpiInproj {
    bf16_t* Pf; bf16_t* Vt; float* ncv; bf16_t* Qn; bf16_t* Kn; float* nck; const float* qg; const float* kg; LAS float* xch  ;
    __device__ __forceinline__ void operator()(const f32x4 (&acc)[2][2][4][2], const Unit& u, int wr, int wc, int fr, int fq) const {
        if (u.z == 1) {
            const int vr0 = (u.pn - 4) * 256 + wr * 64 + fr, tok0 = u.pm * 256 + wc * 32 + 8 * fq;
            const bool ctx = (u.pm < 32);
#pragma unroll
            for (int ai = 0; ai < 2; ++ai)
#pragma unroll
                for (int m = 0; m < 4; ++m) { const int vr = vr0 + ai * 128 + m * 16;
#pragma unroll
                    for (int bj = 0; bj < 2; ++bj) { const int tok = tok0 + bj * 128; const f32x4 v0 = acc[ai][bj][m][0], v1 = acc[ai][bj][m][1];
                        *(u32x4*)(Vt + (size_t)vr * NTOK + tok) = pack8(v0, v1);
                        if (ctx) { float* o = ncv + (size_t)tok * 512 + vr;
#pragma unroll
                            for (int j = 0; j < 4; ++j) { __builtin_nontemporal_store(v0[j], o + (size_t)j * 512); __builtin_nontemporal_store(v1[j], o + (size_t)(j + 4) * 512); } } } }
            return;
        }
        if (u.pn >= 6) { EpiPlain<0> e{Pf, 512}; e(acc, u, wr, wc, fr, fq); return; }
        const bool isk = u.pn >= 2, lat = u.pm >= 32; const int part = wc & 1, wid = wr * 4 + wc;
        float g8[2][4];
#pragma unroll
        for (int n = 0; n < 2; ++n)
#pragma unroll
            for (int j = 0; j < 4; ++j) g8[n][j] = (isk ? kg : qg)[32 * part + 8 * fq + 4 * n + j];
        float ssv[2][4][2];
#pragma unroll
        for (int ai = 0; ai < 2; ++ai)
#pragma unroll
            for (int m = 0; m < 4; ++m)
#pragma unroll
                for (int bj = 0; bj < 2; ++bj) { const f32x4 v0 = acc[ai][bj][m][0], v1 = acc[ai][bj][m][1];
                    float sq = (v0.x * v0.x + v0.y * v0.y) + (v0.z * v0.z + v0.w * v0.w) + (v1.x * v1.x + v1.y * v1.y) + (v1.z * v1.z + v1.w * v1.w);
                    sq += __shfl_xor(sq, 16); sq += __shfl_xor(sq, 32); ssv[ai][m][bj] = sq;
                    if (fq == 0) xch[wid * 256 + (ai * 8 + m * 2 + bj) * 16 + fr] = sq; }
        asm volatile("s_waitcnt lgkmcnt(0)" ::: "memory"); __builtin_amdgcn_s_barrier();
        const LAS float* px = xch + (wid ^ 1) * 256;
        float inv8[2][4];
#pragma unroll
        for (int n = 0; n < 2; ++n)
#pragma unroll
            for (int j = 0; j < 4; ++j) inv8[n][j] = exp2f(-(float)(8 * (fq & 1) + 4 * n + j) * (13.287712379549449f / 16.f));
#pragma unroll
        for (int ai = 0; ai < 2; ++ai)
#pragma unroll
            for (int m = 0; m < 4; ++m) { const int r = ai * 128 + wr * 64 + m * 16 + fr; const int T = u.pm * 256 + r;
                const int ntok = (T - NCTX) & (LSEQ - 1); const float pos = (float)(part ? (ntok & 63) : (ntok >> 6));
#pragma unroll
                for (int bj = 0; bj < 2; ++bj) {
                    const float tot = ssv[ai][m][bj] + px[(ai * 8 + m * 2 + bj) * 16 + fr]; const float rstd = rsqrtf(tot * (1.f / 64.f) + EPS);
                    float y[2][4];
#pragma unroll
                    for (int n = 0; n < 2; ++n)
#pragma unroll
                        for (int j = 0; j < 4; ++j) y[n][j] = acc[ai][bj][m][n][j] * rstd * g8[n][j];
                    if (lat) {
#pragma unroll
                        for (int n = 0; n < 2; ++n)
#pragma unroll
                            for (int j = 0; j < 4; ++j) { float sn, cs; __sincosf(pos * inv8[n][j], &sn, &cs); const float pv = __shfl_xor(y[n][j], 32);
                                y[n][j] = (fq >= 2) ? (y[n][j] * cs + pv * sn) : (y[n][j] * cs - pv * sn); }
                    }
                    const size_t o = (size_t)T * 512 + (u.pn & 1) * 256 + bj * 128 + wc * 32 + 8 * fq;
                    if (isk) {
                        u32x4 w; w.x = pk2(y[0][0], y[0][1]); w.y = pk2(y[0][2], y[0][3]); w.z = pk2(y[1][0], y[1][1]); w.w = pk2(y[1][2], y[1][3]);
                        *(u32x4*)(Kn + o) = w;
                        if (!lat) { __builtin_nontemporal_store((f32x4){y[0][0], y[0][1], y[0][2], y[0][3]}, (f32x4*)(nck + o)); __builtin_nontemporal_store((f32x4){y[1][0], y[1][1], y[1][2], y[1][3]}, (f32x4*)(nck + o + 4)); }
                    } else {
                        u32x4 w; w.x = pk2(y[0][0] * QSCALE, y[0][1] * QSCALE); w.y = pk2(y[0][2] * QSCALE, y[0][3] * QSCALE); w.z = pk2(y[1][0] * QSCALE, y[1][1] * QSCALE); w.w = pk2(y[1][2] * QSCALE, y[1][3] * QSCALE);
                        *(u32x4*)(Qn + o) = w;
                    }
                } }
    }
};

struct EpiFourLocal {
    bf16_t* GtC; bf16_t* GtL;
    __device__ __forceinline__ void operator()(const f32x4 (&acc)[2][2][4][2], const Unit& u, int wr, int wc, int fr, int fq) const {
        const int g = u.pn, tt = u.pm; bf16_t* base; int ld, csoff;
        if (tt < 32) { base = GtC + (size_t)((tt * 4 + g) * 128) * 512; ld = 512; csoff = 256; }
        else { const int lt = tt - 32, b = lt >> 3; base = GtL + (size_t)((b * 4 + g) * 128) * 4096 + (lt & 7) * 256; ld = 4096; csoff = 2048; }
        base += wc * 32 + 8 * fq;
#pragma unroll
        for (int ai = 0; ai < 2; ++ai)
#pragma unroll
            for (int m = 0; m < 4; ++m) { const int e = wr * 64 + m * 16 + fr; bf16_t* rowp = base + (size_t)e * ld + ai * csoff;
#pragma unroll
                for (int bj = 0; bj < 2; ++bj) *(u32x4*)(rowp + bj * 128) = pack8(acc[ai][bj][m][0], acc[ai][bj][m][1]); }
    }
};

struct EpiResid {
    const float* Rlo; const float* Rhi; const float* gate  ; float* out;
    __device__ __forceinline__ void operator()(const f32x4 (&acc)[2][2][4][2], const Unit& u, int wr, int wc, int fr, int fq) const {
        const int T0 = u.pm * 256; const int mi = (T0 < NCTX) ? 0 : 1 + ((T0 - NCTX) >> 11);
        const float* R = (T0 < NCTX) ? Rlo + (size_t)T0 * D : Rhi + (size_t)(T0 - NCTX) * D;
        const int c0 = u.pn * 256 + wc * 32 + 8 * fq;
        f32x4 gv[2][2];
#pragma unroll
        for (int bj = 0; bj < 2; ++bj)
#pragma unroll
            for (int n = 0; n < 2; ++n) gv[bj][n] = *(const f32x4*)(gate + (size_t)mi * 6144 + c0 + bj * 128 + 4 * n);
#pragma unroll
        for (int ai = 0; ai < 2; ++ai)
#pragma unroll
        for (int mh = 0; mh < 2; ++mh) {
            f32x4 rv[2][2][2];
#pragma unroll
            for (int ml = 0; ml < 2; ++ml)
#pragma unroll
                for (int bj = 0; bj < 2; ++bj) { const size_t off = (size_t)(ai * 128 + wr * 64 + (2 * mh + ml) * 16 + fr) * D + c0 + bj * 128;
                    rv[ml][bj][0] = __builtin_nontemporal_load((const f32x4*)(R + off)); rv[ml][bj][1] = __builtin_nontemporal_load((const f32x4*)(R + off + 4)); }
#pragma unroll
            for (int ml = 0; ml < 2; ++ml)
#pragma unroll
                for (int bj = 0; bj < 2; ++bj) { const int m = 2 * mh + ml; const size_t off = (size_t)(ai * 128 + wr * 64 + m * 16 + fr) * D + c0 + bj * 128;
                    __builtin_nontemporal_store(rv[ml][bj][0] + gv[bj][0] * acc[ai][bj][m][0], (f32x4*)(out + (size_t)T0 * D + off));
                    __builtin_nontemporal_store(rv[ml][bj][1] + gv[bj][1] * acc[ai][bj][m][1], (f32x4*)(out + (size_t)T0 * D + off + 4)); }
        }
    }
};

struct EpiOut {
    const float* xlo; const float* xhi; const float* mod; const float* n2g; float* out; bf16_t* A2; float* ssq;
    __device__ __forceinline__ void operator()(const f32x4 (&acc)[2][2][4][2], const Unit& u, int wr, int wc, int fr, int fq) const {
        const int T0 = u.pm * 256; const int mi = (T0 < NCTX) ? 0 : 1 + ((T0 - NCTX) >> 11);
        const float* R = (T0 < NCTX) ? xlo + (size_t)T0 * D : xhi + (size_t)(T0 - NCTX) * D;
        const int c0 = u.pn * 256 + wc * 32 + 8 * fq; const float* mrow = mod + (size_t)mi * 6144;
        f32x4 gv[2][2], gm[2][2];
#pragma unroll
        for (int bj = 0; bj < 2; ++bj)
#pragma unroll
            for (int n = 0; n < 2; ++n) { const int c = c0 + bj * 128 + 4 * n; gv[bj][n] = *(const f32x4*)(mrow + 2048 + c); gm[bj][n] = *(const f32x4*)(n2g + c) * (*(const f32x4*)(mrow + 4096 + c) + 1.0f); }
#pragma unroll
        for (int ai = 0; ai < 2; ++ai)
#pragma unroll
            for (int m = 0; m < 4; ++m) { const int r = ai * 128 + wr * 64 + m * 16 + fr; float ss = 0.f;
#pragma unroll
                for (int bj = 0; bj < 2; ++bj) { const size_t off = (size_t)r * D + c0 + bj * 128;
                    const f32x4 x0 = __builtin_nontemporal_load((const f32x4*)(R + off)) + gv[bj][0] * acc[ai][bj][m][0], x1 = __builtin_nontemporal_load((const f32x4*)(R + off + 4)) + gv[bj][1] * acc[ai][bj][m][1];
                    __builtin_nontemporal_store(x0, (f32x4*)(out + (size_t)T0 * D + off)); __builtin_nontemporal_store(x1, (f32x4*)(out + (size_t)T0 * D + off + 4));
                    ss += (x0.x * x0.x + x0.y * x0.y) + (x0.z * x0.z + x0.w * x0.w) + (x1.x * x1.x + x1.y * x1.y) + (x1.z * x1.z + x1.w * x1.w);
                    *(u32x4*)(A2 + (size_t)T0 * D + off) = pack8(x0 * gm[bj][0], x1 * gm[bj][1]); }
                ss += __shfl_xor(ss, 16); ss += __shfl_xor(ss, 32);
                if (fq == 0) ssq[(size_t)(T0 + r) * 16 + u.pn * 4 + wc] = ss; }
    }
};

struct EpiUp {
    bf16_t* U; const float* ssq; const float* bias2;
    __device__ __forceinline__ void operator()(const f32x4 (&acc)[2][2][4][2], const Unit& u, int wr, int wc, int fr, int fq) const {
        const int T0 = u.pm * 256; const int mi = (T0 < NCTX) ? 0 : 1 + ((T0 - NCTX) >> 11);
        const int c0 = u.pn * 256 + wc * 32 + 8 * fq;
        f32x4 bv[2][2];
#pragma unroll
        for (int bj = 0; bj < 2; ++bj)
#pragma unroll
            for (int n = 0; n < 2; ++n) bv[bj][n] = *(const f32x4*)(bias2 + (size_t)mi * DFF + c0 + bj * 128 + 4 * n);
        float rs[2][4];
#pragma unroll
        for (int ai = 0; ai < 2; ++ai)
#pragma unroll
            for (int m = 0; m < 4; ++m) { const f32x4* sp = (const f32x4*)(ssq + (size_t)(T0 + ai * 128 + wr * 64 + m * 16 + fr) * 16); const f32x4 s4 = (sp[0] + sp[1]) + (sp[2] + sp[3]);
                rs[ai][m] = rsqrtf(((s4.x + s4.y) + (s4.z + s4.w)) * (1.f / D) + EPS); }
#pragma unroll
        for (int ai = 0; ai < 2; ++ai)
#pragma unroll
            for (int m = 0; m < 4; ++m) { const int r = ai * 128 + wr * 64 + m * 16 + fr;
                const float rstd = rs[ai][m];
                bf16_t* rowp = U + (size_t)(T0 + r) * DFF + c0;
#pragma unroll
                for (int bj = 0; bj < 2; ++bj) { f32x4 v0 = acc[ai][bj][m][0] * rstd + bv[bj][0], v1 = acc[ai][bj][m][1] * rstd + bv[bj][1];
#pragma unroll
                    for (int j = 0; j < 4; ++j) { const float a = fmaxf(v0[j], 0.f), b = fmaxf(v1[j], 0.f); v0[j] = a * a; v1[j] = b * b; }
                    *(u32x4*)(rowp + bj * 128) = pack8(v0, v1); } }
    }
};

struct SchedStd {
    const char* A; const char* B; int nM, nN; size_t atile, btile  ; int ldc; int G, c;
    __device__ __forceinline__ bool next(int i, Unit& u) const {
        const int L = i * G + c; if (L >= nM * nN) return false;
        pg8::tile_order(L, nM, nN, u.pm, u.pn); u.z = 0; u.pad = 0;
        u.a = A + (size_t)u.pm * atile; u.b = B + (size_t)u.pn * btile; u.coff = (size_t)u.pm * 256 * ldc + (size_t)u.pn * 256; return true;
    }
};
__device__ __forceinline__ bool inproj_slot(int i, int G, int c, int& pm, int& pn) {
    const int vcu = (G % 8 == 0) ? (c % 8) * (G / 8) + c / 8 : c; const int s = i * G + vcu; if (s >= 512) return false;
    pm = (s & 255) >> 2; pn = 4 * (s >> 8) + (s & 3); return true;
}
struct SchedInproj {
    const char* H; const char* W; int G, c;
    __device__ __forceinline__ bool next(int i, Unit& u) const {
        if (!inproj_slot(i, G, c, u.pm, u.pn)) return false; u.pad = 0;
        const char* h = H + (size_t)u.pm * 256 * D * 2; const char* w = W + (size_t)u.pn * 256 * D * 2;
        if (u.pn == 4 || u.pn == 5) { u.z = 1; u.a = w; u.b = h; u.coff = 0; }
        else { u.z = 0; u.a = h; u.b = w; u.coff = (size_t)u.pm * 256 * 512 + (size_t)(u.pn >= 6 ? u.pn - 6 : 0) * 256; }
        return true;
    }
};
struct SchedFourChain {
    const char* Mt; const char* Pf; int G, c;
    __device__ __forceinline__ bool next(int j, Unit& u) const {
        int nf = 0, pm, pn;
        for (int i = 0; inproj_slot(i, G, c, pm, pn); ++i) {
            if (pn >= 6) { if ((j >> 1) == nf) { const int g = 2 * (pn - 6) + (j & 1); u.pm = pm; u.pn = g; u.z = 0; u.pad = 0; u.coff = 0;
                    u.a = Mt + (size_t)g * 256 * 128 * 2; u.b = Pf + ((size_t)pm * 256 * 512 + g * 128) * 2; return true; }
                ++nf; } }
        return false;
    }
};
struct SchedPosL {
    const char* Dft; const char* Gt; int G, c;
    __device__ __forceinline__ bool next(int i, Unit& u) const {
        const int L = i * G + c; if (L >= 256) return false;
        u.z = L & 3; const int t = L >> 2; u.pm = t & 7; u.pn = t >> 3; u.pad = 0;
        u.a = Dft + ((size_t)u.pm * 256 * 2048 + u.z * 512) * 2; u.b = Gt + ((size_t)u.pn * 256 * 4096 + (u.pm >= 4 ? 2048 : 0) + u.z * 512) * 2;
        u.coff = (size_t)u.z * 2048 * 2048 + (size_t)u.pm * 256 * 2048 + u.pn * 256; return true;
    }
};
struct SchedPosC {
    const char* Dft; const char* Gt; int G, c;
    __device__ __forceinline__ bool next(int i, Unit& u) const {
        const int L = i * G + c; if (L >= 64) return false;
        u.pm = 0; u.pn = L; u.z = 0; u.pad = 0; u.a = Dft; u.b = Gt + (size_t)L * 256 * 512 * 2;
        u.coff = (size_t)(L >> 1) * 256 * D + 512 + (L & 1) * 256; return true;
    }
};

struct TrItem { const float* W; bf16_t* WT; int K, N, item; };
__device__ __forceinline__ void transpose_load(const TrItem& t, f32x4 (&v)[8], int lane) {
    const int nblk = t.N / 32, kb = t.item / nblk, nb = t.item % nblk, k0 = 64 * kb, n0 = 32 * nb;
#pragma unroll
    for (int i = 0; i < 8; ++i) v[i] = __builtin_nontemporal_load((const f32x4*)(t.W + (size_t)(k0 + 8 * i + (lane >> 3)) * t.N + n0 + (lane & 7) * 4));
}
__device__ __forceinline__ void transpose_store(const TrItem& t, const f32x4 (&v)[8], LAS float* scr, int lane) {
    const int nblk = t.N / 32, kb = t.item / nblk, nb = t.item % nblk, k0 = 64 * kb, n0 = 32 * nb;
#pragma unroll
    for (int i = 0; i < 8; ++i) { LAS float* d = scr + (8 * i + (lane >> 3)) * 33 + (lane & 7) * 4; d[0] = v[i].x; d[1] = v[i].y; d[2] = v[i].z; d[3] = v[i].w; }
    LDS_WAIT(); asm volatile("" ::: "memory");
    const int c = lane & 7;
#pragma unroll
    for (int j = 0; j < 4; ++j) { const int n = (lane >> 3) + 8 * j; const LAS float* s = scr + (8 * c) * 33 + n;
        u32x4 o; o.x = pk2(s[0 * 33], s[1 * 33]); o.y = pk2(s[2 * 33], s[3 * 33]); o.z = pk2(s[4 * 33], s[5 * 33]); o.w = pk2(s[6 * 33], s[7 * 33]);
        *(u32x4*)(t.WT + (size_t)(n0 + n) * t.K + k0 + 8 * c) = o; }
    LDS_WAIT(); asm volatile("" ::: "memory");
}

struct Args {
    const float *x_prompt, *x_sample, *c, *cache_k, *cache_v, *c_ctx, *w_mod, *b_mod, *norm1_g, *w_in, *q_norm_g, *k_norm_g, *lq1, *lk1, *lq2, *lk2, *subln_g, *w_four, *w_out, *norm2_g, *w1, *w2;
    float* out; unsigned char* ws; int ph_lo, ph_hi;
};

__device__ __forceinline__ void rowpass_h(const float* xlo, const float* xhi, const float* gvec, const float* mod, int sh_off, int sc_off, bf16_t* H, int gw, int NGW, int lane) {
    for (int T0 = gw * 8; T0 < NTOK; T0 += NGW * 8) {
        const float* xr = (T0 < NCTX) ? xlo + (size_t)T0 * D : xhi + (size_t)(T0 - NCTX) * D;
        const int mi = (T0 < NCTX) ? 0 : 1 + ((T0 - NCTX) >> 11);
        const float* mrow = mod + (size_t)mi * 6144;
        f32x4 gm[4], sh[4], v[8][4];
#pragma unroll
        for (int k = 0; k < 8; ++k)
#pragma unroll
            for (int j = 0; j < 4; ++j) v[k][j] = __builtin_nontemporal_load((const f32x4*)(xr + (size_t)k * D) + lane + 64 * j);
#pragma unroll
        for (int j = 0; j < 4; ++j) { const int cidx = 4 * (lane + 64 * j);
            gm[j] = *(const f32x4*)(gvec + cidx) * (*(const f32x4*)(mrow + sc_off + cidx) + 1.0f); sh[j] = *(const f32x4*)(mrow + sh_off + cidx); }
#pragma unroll
        for (int k = 0; k < 8; ++k) {
            float ss = 0.f;
#pragma unroll
            for (int j = 0; j < 4; ++j) ss += (v[k][j].x * v[k][j].x + v[k][j].y * v[k][j].y) + (v[k][j].z * v[k][j].z + v[k][j].w * v[k][j].w);
            const float rstd = rsqrtf(wave_sum(ss) * (1.f / D) + EPS);
#pragma unroll
            for (int j = 0; j < 4; ++j) { const int cidx = 4 * (lane + 64 * j);
                const f32x4 o = v[k][j] * rstd * gm[j] + sh[j];
                u32x2 w; w.x = pk2(o.x, o.y); w.y = pk2(o.z, o.w);
                *(u32x2*)(H + (size_t)(T0 + k) * D + cidx) = w; }
        }
    }
}

struct AttnSeg { const bf16_t* K; const bf16_t* Vt; int vstride; int ntiles; };
constexpr int AT_KB = 34816  , AT_VB = 34816  , AT_K0 = 0, AT_V0 = 2 * AT_KB;
__device__ __forceinline__ void attn_unit(LAS unsigned char* lds, const bf16_t* Qrow0, const AttnSeg s0, const AttnSeg s1, float Mb, float lam, const float* subg, bf16_t* Xrow0) {
    int tid = threadIdx.x; asm volatile("" : "+v"(tid));
    const int wid = tid >> 6, lane = tid & 63, qblk = wid >> 1, st = wid & 1, q = lane & 31, hi = lane >> 5;
    bf16x8 qf[4];
#pragma unroll
    for (int kk = 0; kk < 4; ++kk) qf[kk] = *(const bf16x8*)(Qrow0 + (size_t)(qblk * 32 + q) * 512 + st * 64 + kk * 16 + hi * 8);
    f32x16 oacc[4];
#pragma unroll
    for (int eb = 0; eb < 4; ++eb)
#pragma unroll
        for (int i = 0; i < 16; ++i) oacc[eb][i] = 0.f;
    float lsum = 0.f;
    const int nt = s0.ntiles + s1.ntiles;
    u32x4 kreg[4], vreg[4];
    const int kkey = tid >> 4, kpart = tid & 15;
    const int pir = (q & 0x13) | ((q & 4) << 1) | ((q & 8) >> 1);
#define AT_LOAD(t) do { const bool in0 = (t) < s0.ntiles; const int tl = in0 ? (t) : (t) - s0.ntiles; const bf16_t* Kp = (in0 ? s0.K : s1.K) + (size_t)tl * 128 * 512; \
        const bf16_t* Vp = (in0 ? s0.Vt : s1.Vt) + tl * 128; const int vs = in0 ? s0.vstride : s1.vstride; \
        _Pragma("unroll") for (int i_ = 0; i_ < 4; ++i_) { kreg[i_] = *(const u32x4*)(Kp + (size_t)(kkey + 32 * i_) * 512 + kpart * 8); vreg[i_] = *(const u32x4*)(Vp + (size_t)(kkey + 32 * i_) * vs + kpart * 8); } } while (0)
#define AT_STORE(buf) do { LAS unsigned char* kb_ = lds + AT_K0 + (buf) * AT_KB; LAS unsigned char* vb_ = lds + AT_V0 + (buf) * AT_VB; \
        _Pragma("unroll") for (int i_ = 0; i_ < 4; ++i_) { *(LAS u32x4*)(kb_ + (kkey + 32 * i_) * 272 + kpart * 16) = kreg[i_]; *(LAS u32x4*)(vb_ + (kkey + 32 * i_) * 272 + kpart * 16) = vreg[i_]; } } while (0)
    AT_LOAD(0); AT_STORE(0); __syncthreads();
    for (int t = 0; t < nt; ++t) {
        const int buf = t & 1;
        if (t + 1 < nt) AT_LOAD(t + 1);
#pragma unroll
        for (int sub = 0; sub < 2; ++sub) {
        const LAS unsigned char* kb = lds + AT_K0 + buf * AT_KB + sub * 64 * 272 + st * 128 + hi * 16;
        const LAS unsigned char* vb = lds + AT_V0 + buf * AT_VB + q * 272 + sub * 128 + hi * 16;
        f32x16 sacc[2];
#pragma unroll
        for (int k2 = 0; k2 < 2; ++k2) {
#pragma unroll
            for (int i = 0; i < 16; ++i) sacc[k2][i] = -Mb;
#pragma unroll
            for (int kk = 0; kk < 4; ++kk) { const bf16x8 a = *(const LAS bf16x8*)(kb + (k2 * 32 + pir) * 272 + kk * 32);
                sacc[k2] = __builtin_amdgcn_mfma_f32_32x32x16_bf16(a, qf[kk], sacc[k2], 0, 0, 0); }
        }
        bf16x8 pf[4];
#pragma unroll
        for (int k2 = 0; k2 < 2; ++k2) {
            float p[16];
#pragma unroll
            for (int i = 0; i < 16; ++i) { p[i] = __builtin_amdgcn_exp2f(sacc[k2][i]); lsum += p[i]; }
#pragma unroll
            for (int u = 0; u < 2; ++u) { u32x4 w; w.x = pk2(p[8 * u + 0], p[8 * u + 1]); w.y = pk2(p[8 * u + 2], p[8 * u + 3]); w.z = pk2(p[8 * u + 4], p[8 * u + 5]); w.w = pk2(p[8 * u + 6], p[8 * u + 7]);
                pf[2 * k2 + u] = __builtin_bit_cast(bf16x8, w); }
        }
#pragma unroll
        for (int eb = 0; eb < 4; ++eb)
#pragma unroll
            for (int kk = 0; kk < 4; ++kk) { const bf16x8 a = *(const LAS bf16x8*)(vb + eb * 32 * 272 + kk * 32);
                oacc[eb] = __builtin_amdgcn_mfma_f32_32x32x16_bf16(a, pf[kk], oacc[eb], 0, 0, 0); }
        }
        if (t + 1 < nt) AT_STORE(buf ^ 1);
        __syncthreads();
    }
#undef AT_LOAD
#undef AT_STORE
    const float l = lsum + __shfl_xor(lsum, 32);
    const float scale = (st == 0) ? 1.f / l : -lam / l;
    LAS float* Tq = (LAS float*)(lds + qblk * (32 * 129 * 4));
    if (st == 1) {
#pragma unroll
        for (int eb = 0; eb < 4; ++eb)
#pragma unroll
            for (int i = 0; i < 16; ++i) { const int e = eb * 32 + (i & 3) + 8 * (i >> 2) + 4 * hi; Tq[q * 129 + e] = oacc[eb][i] * scale; }
    }
    __syncthreads();
    if (st == 0) {
        float ss = 0.f;
#pragma unroll
        for (int eb = 0; eb < 4; ++eb)
#pragma unroll
            for (int i = 0; i < 16; ++i) { const int e = eb * 32 + (i & 3) + 8 * (i >> 2) + 4 * hi; const float v = oacc[eb][i] * scale + Tq[q * 129 + e]; oacc[eb][i] = v; ss += v * v; }
        ss += __shfl_xor(ss, 32);
        const float rstd = rsqrtf(ss * (1.f / 128.f) + EPS) * (1.f - LAM_INIT);
#pragma unroll
        for (int eb = 0; eb < 4; ++eb)
#pragma unroll
            for (int i = 0; i < 16; ++i) { const int e = eb * 32 + (i & 3) + 8 * (i >> 2) + 4 * hi; Tq[q * 129 + e] = oacc[eb][i] * rstd; }
    }
    __syncthreads();
    {
        const int l2 = st * 64 + lane;
        const f32x4 g0 = *(const f32x4*)(subg + (l2 & 15) * 8), g1 = *(const f32x4*)(subg + (l2 & 15) * 8 + 4);
#pragma unroll
        for (int it = 0; it < 4; ++it) { const int idx = it * 128 + l2, row = idx >> 4, c8 = (idx & 15) * 8; const LAS float* s = Tq + row * 129 + c8;
            u32x4 w; w.x = pk2(s[0] * g0.x, s[1] * g0.y); w.y = pk2(s[2] * g0.z, s[3] * g0.w); w.z = pk2(s[4] * g1.x, s[5] * g1.y); w.w = pk2(s[6] * g1.z, s[7] * g1.w);
            *(u32x4*)(Xrow0 + (size_t)(qblk * 32 + row) * D + c8) = w; }
    }
    __syncthreads();
}

#define XB_XCNT(j)  (256  + 64 * (j))
#define XB_XSUB(j)  (1280 + 64 * (j))
#define XB_XGEN(j)  (2304 + 64 * (j))
#define XB_TOP      3328
#define XB_TOPGEN   3392
#define XCD_BAR_WORDS 3456
__device__ __forceinline__ unsigned xb_ld(unsigned* p)              { return __hip_atomic_load(p, __ATOMIC_RELAXED, __HIP_MEMORY_SCOPE_AGENT); }
__device__ __forceinline__ unsigned xb_add(unsigned* p, unsigned v) { return __hip_atomic_fetch_add(p, v, __ATOMIC_RELAXED, __HIP_MEMORY_SCOPE_AGENT); }
__device__ __forceinline__ unsigned xb_xcc_id() { return (unsigned)__builtin_amdgcn_s_getreg((3 << 11) | 20) & 0xFu; }
__device__ __forceinline__ void grid_bar(unsigned* bar, volatile LAS unsigned* st) {
    asm volatile("s_waitcnt vmcnt(0) lgkmcnt(0)" ::: "memory");
    __syncthreads();
    if (threadIdx.x == 0) {
        const unsigned x = xb_xcc_id();
        unsigned nloc = st[0], nx = st[1];
        if (nloc == 0u) {
            const unsigned Gt = gridDim.x;
            for (;;) { unsigned sum = 0u, cnt = 0u, mine = 0u;
#pragma unroll
                for (unsigned j = 0; j < 16; ++j) { const unsigned c = xb_ld(&bar[XB_XCNT(j)]); sum += c; cnt += (c > 0u) ? 1u : 0u; mine = (j == x) ? c : mine; }
                if (sum == Gt) { nloc = mine; nx = cnt; break; }
                __builtin_amdgcn_s_sleep(1); }
            st[0] = nloc; st[1] = nx;
        }
        const unsigned old = xb_add(&bar[XB_XSUB(x)], 1u);
        const unsigned gen = old / nloc;
        if (old + 1u == (gen + 1u) * nloc) {
            __builtin_amdgcn_fence(__ATOMIC_RELEASE, "agent");
            asm volatile("s_waitcnt vmcnt(0)" ::: "memory");
            const unsigned og = xb_add(&bar[XB_TOP], 1u);
            const unsigned tg = og / nx;
            if (og + 1u == (tg + 1u) * nx) xb_add(&bar[XB_TOPGEN], 1u);
            else { while (xb_ld(&bar[XB_TOPGEN]) == tg) __builtin_amdgcn_s_sleep(1); }
            __builtin_amdgcn_fence(__ATOMIC_ACQUIRE, "agent");
            xb_add(&bar[XB_XGEN(x)], 1u);
            asm volatile("s_waitcnt vmcnt(0)" ::: "memory");
        } else {
            while (xb_ld(&bar[XB_XGEN(x)]) == gen) __builtin_amdgcn_s_sleep(1);
            __builtin_amdgcn_fence(__ATOMIC_ACQUIRE, "agent");
            asm volatile("s_waitcnt vmcnt(0)" ::: "memory");
        }
    }
    __syncthreads();
}

template <bool COOP>
__global__ void __launch_bounds__(512) fwd_kernel(Args A) {
    extern __shared__ __attribute__((aligned(16))) unsigned char lds_raw[];
    LAS unsigned char* lds = (LAS unsigned char*)lds_raw;
    const int tid = threadIdx.x, lane = tid & 63, wid = __builtin_amdgcn_readfirstlane(tid >> 6);
    const int G = gridDim.x, bx = blockIdx.x;
    const int gw = bx * 8 + wid, NGW = G * 8;
    unsigned char* ws = A.ws;
    float* mod = (float*)(ws + WS_MOD); float* bmax = (float*)(ws + WS_BMAX);
    bf16_t* WinT = (bf16_t*)(ws + WS_WIN); bf16_t* WoutT = (bf16_t*)(ws + WS_WOUT); bf16_t* W1T = (bf16_t*)(ws + WS_W1); bf16_t* W2T = (bf16_t*)(ws + WS_W2);
    bf16_t* Mt = (bf16_t*)(ws + WS_MT); bf16_t* DftC = (bf16_t*)(ws + WS_DFTC); bf16_t* DftL = (bf16_t*)(ws + WS_DFTL);
    bf16_t* Hb = (bf16_t*)(ws + WS_H); bf16_t* X2 = (bf16_t*)(ws + WS_X2); bf16_t* A2 = (bf16_t*)(ws + WS_A2); float* ssq = (float*)(ws + WS_SSQ); float* bias2 = (float*)(ws + WS_BIAS2);
    bf16_t* P = (bf16_t*)(ws + WS_P); bf16_t* Fpart = (bf16_t*)(ws + WS_FPART); bf16_t* Vt = (bf16_t*)(ws + WS_VT); bf16_t* U = (bf16_t*)(ws + WS_U);
    bf16_t* Kc = (bf16_t*)(ws + WS_KC); bf16_t* Vtc = (bf16_t*)(ws + WS_VTC); bf16_t* Qn = (bf16_t*)(ws + WS_QN); bf16_t* Kn = (bf16_t*)(ws + WS_KN);
    bf16_t* GtL = (bf16_t*)(ws + WS_GTL); bf16_t* GtC = (bf16_t*)(ws + WS_GTC);
    float* out_y = A.out; float* out_nck = A.out + (size_t)NTOK * D; float* out_ncv = out_nck + (size_t)NCTX * 512;
    const int lo = A.ph_lo, hi = A.ph_hi;
#define IN(k) (lo <= (k) && (k) < hi)
    unsigned* barw = (unsigned*)(ws + WS_BAR);
    volatile LAS unsigned* bst = (volatile LAS unsigned*)(lds + 139264);
    if (COOP && A.ph_lo < 0) cg::this_grid().sync();
    if (COOP) { if (tid == 0) { bst[0] = 0u; bst[1] = 0u; (void)xb_add(&barw[XB_XCNT(xb_xcc_id())], 1u); } __syncthreads(); }
#define SEAM(k) do { if (COOP && IN(k) && IN((k) + 1)) { for (int rb = 0; rb < NREP(13); ++rb) grid_bar(barw, bst); } } while (0)

    for (int rep = 0; rep < NREP(0); ++rep) if (IN(0)) {
        LAS float* tab = (LAS float*)(lds);
        LAS float* scs = (LAS float*)(lds + 8192);
        LAS float* red = (LAS float*)(lds + 8192 + 20480);
        LAS float* scr = (LAS float*)(lds + 40960 + wid * 8448);
        for (int i = tid; i < 2048; i += 512) tab[i] = cospif((float)i * (1.f / 1024.f));
        {   float cv[10];
#pragma unroll
            for (int j = 0; j < 10; ++j) { const int i = tid + 512 * j, mi = i >> 10, k = i & 1023; const float* src = (mi == 0) ? A.c_ctx + k : A.c + (mi - 1) * 1024 + k; cv[j] = *src; }
#pragma unroll
            for (int j = 0; j < 10; ++j) scs[tid + 512 * j] = cv[j] / (1.f + __expf(-cv[j])); }
        __syncthreads();
        for (int rp = 0; rp < NREP(14); ++rp)
        for (int item = bx; item < 192; item += G) {
            const int cl = tid & 31, kg = tid >> 5, col = item * 32 + cl, kb = kg * 64; float a0 = 0.f, a1 = 0.f, a2 = 0.f, a3 = 0.f, a4 = 0.f;
            float wv[64];
#pragma unroll
            for (int k = 0; k < 64; ++k) wv[k] = __builtin_nontemporal_load(A.w_mod + (size_t)(kb + k) * 6144 + col);
#pragma unroll
            for (int k = 0; k < 64; ++k) { const float w = wv[k]; const int kk = kb + k;
                a0 += scs[kk] * w; a1 += scs[1024 + kk] * w; a2 += scs[2048 + kk] * w; a3 += scs[3072 + kk] * w; a4 += scs[4096 + kk] * w; }
            red[(kg * 5 + 0) * 32 + cl] = a0; red[(kg * 5 + 1) * 32 + cl] = a1; red[(kg * 5 + 2) * 32 + cl] = a2; red[(kg * 5 + 3) * 32 + cl] = a3; red[(kg * 5 + 4) * 32 + cl] = a4;
            __syncthreads();
            if (tid < 160) { const int mi = tid >> 5; float s_ = A.b_mod[item * 32 + cl];
#pragma unroll
                for (int w = 0; w < 16; ++w) s_ += red[(w * 5 + mi) * 32 + cl];
                mod[(size_t)mi * 6144 + item * 32 + cl] = s_; }
            __syncthreads();
        }
        for (int rp = 0; rp < NREP(15); ++rp) {
        for (int rr = bx; rr < 1024; rr += G) { const int r = rr * 2 + (tid >> 8), sn_ = r >> 10, n = r & 1023, n0 = (tid & 255) * 8; float v[8];
            const int idx0 = (n * n0) & 2047; float c_ = tab[idx0], s_ = tab[(idx0 - 512) & 2047]; const float c1 = tab[n], s1 = tab[(n - 512) & 2047];
#pragma unroll
            for (int j = 0; j < 8; ++j) { v[j] = (sn_ ? s_ : c_) * 0.02209708691207961f; const float cn = c_ * c1 - s_ * s1; s_ = s_ * c1 + c_ * s1; c_ = cn; }
            u32x4 w; w.x = pk2(v[0], v[1]); w.y = pk2(v[2], v[3]); w.z = pk2(v[4], v[5]); w.w = pk2(v[6], v[7]);
            *(u32x4*)(DftL + (size_t)r * 2048 + n0) = w; }
        for (int ch = bx * 512 + tid; ch < 16384; ch += G * 512) { const int r = ch >> 6, c0 = (ch & 63) * 8, cs = c0 >> 8, n0 = c0 & 255; float v[8];
#pragma unroll
            for (int j = 0; j < 8; ++j) { const int idx = ((r * (n0 + j)) & 255) * 8; v[j] = (cs ? -tab[(idx - 512) & 2047] : tab[idx]) * 0.0625f; }
            u32x4 w; w.x = pk2(v[0], v[1]); w.y = pk2(v[2], v[3]); w.z = pk2(v[4], v[5]); w.w = pk2(v[6], v[7]);
            *(u32x4*)(DftC + (size_t)r * 512 + c0) = w; }
        {   LAS float* wl = red;
            LAS float* Tt = (LAS float*)(lds + 40960);
            for (int blk = bx; blk < 256; blk += G) { const int combo = blk >> 5, g = combo >> 1, cs = combo & 1, e0 = (blk & 31) * 4;
                __syncthreads();
                wl[tid] = A.w_four[(size_t)g * 16384 + (tid >> 2) * 128 + e0 + (tid & 3)];
                for (int i = tid; i < 16384; i += 512) { const float a_ = (float)(((i & 127) * (i >> 7)) & 127) * (1.f / 64.f); Tt[i] = cs ? sinpif(a_) : cospif(a_); }
                __syncthreads();
                const int el = tid >> 7, c = tid & 127; float s_ = 0.f;
#pragma unroll 8
                for (int ep = 0; ep < 128; ++ep) s_ += Tt[ep * 128 + c] * wl[ep * 4 + el];
                Mt[(size_t)g * 32768 + (size_t)(cs * 128 + e0 + el) * 128 + c] = (bf16_t)(pk2(s_ * 0.08838834764831845f, 0.f) & 0xffffu); }
            __syncthreads();
        }
        }
        float kmax = 0.f;
        constexpr int I_IN = 16 * 64, I_OUT = 16 * 32, I_1 = 16 * 128, I_2 = 64 * 32, I_CV = 4 * 128, I_CK = 4 * PAST;
        constexpr int NITEMS = I_IN + I_OUT + I_1 + I_2 + I_CV + I_CK;
        constexpr int NTR = I_IN + I_OUT + I_1 + I_2 + I_CV;
#define TR_DESC(it_, t_) do { int r_ = (it_); \
            if (r_ < I_IN) { t_.W = A.w_in; t_.WT = WinT; t_.K = D; t_.N = 2048; t_.item = r_; } else { r_ -= I_IN; \
            if (r_ < I_OUT) { t_.W = A.w_out; t_.WT = WoutT; t_.K = D; t_.N = D; t_.item = r_; } else { r_ -= I_OUT; \
            if (r_ < I_1) { t_.W = A.w1; t_.WT = W1T; t_.K = D; t_.N = DFF; t_.item = r_; } else { r_ -= I_1; \
            if (r_ < I_2) { t_.W = A.w2; t_.WT = W2T; t_.K = DFF; t_.N = D; t_.item = r_; } else { r_ -= I_2; \
            const int b_ = r_ >> 7; t_.W = A.cache_v + (size_t)b_ * 512 * 512; t_.WT = Vtc + (size_t)b_ * 512 * 512; t_.K = 512; t_.N = 512; t_.item = r_ & 127; } } } } } while (0)
        for (int rp = 0; rp < NREP(16); ++rp) {
        {   TrItem cur, nxt; f32x4 va[8], vb[8]; int it = gw;
            if (it < NTR) { TR_DESC(it, cur); transpose_load(cur, va, lane); }
            while (it < NTR) {
                const int itn = it + NGW; const bool hn = itn < NTR;
                if (hn) { TR_DESC(itn, nxt); transpose_load(nxt, vb, lane); }
                transpose_store(cur, va, scr, lane);
                if (hn) { cur = nxt;
#pragma unroll
                    for (int i = 0; i < 8; ++i) va[i] = vb[i]; }
                it = itn;
            }
        }
#undef TR_DESC
        for (int r = gw; r < I_CK; r += NGW) {
            const float* src = A.cache_k + (size_t)r * 512 + lane * 8; const f32x4 v0 = __builtin_nontemporal_load((const f32x4*)src), v1 = __builtin_nontemporal_load((const f32x4*)(src + 4));
            float ss = (v0.x * v0.x + v0.y * v0.y) + (v0.z * v0.z + v0.w * v0.w) + (v1.x * v1.x + v1.y * v1.y) + (v1.z * v1.z + v1.w * v1.w);
            ss += __shfl_xor(ss, 1); ss += __shfl_xor(ss, 2); ss += __shfl_xor(ss, 4); kmax = fmaxf(kmax, ss);
            *(u32x4*)(Kc + (size_t)r * 512 + lane * 8) = pack8(v0, v1); }
        }
        kmax = wave_max(kmax);
        __syncthreads();
        if (lane == 0) red[wid] = kmax;
        __syncthreads();
        if (tid == 0) { float m = 0.f; for (int w = 0; w < 8; ++w) m = fmaxf(m, red[w]); bmax[bx] = m; }
        __syncthreads();
    }
    SEAM(0);
    for (int rep = 0; rep < NREP(1); ++rep) if (IN(1)) {
        rowpass_h(A.x_prompt, A.x_sample, A.norm1_g, mod, 0, 1024, Hb, gw, NGW, lane);
        int l3 = threadIdx.x & 63; asm volatile("" : "+v"(l3));
        {
            f32x4 shv[5][4];
#pragma unroll
            for (int mi = 0; mi < 5; ++mi)
#pragma unroll
                for (int j = 0; j < 4; ++j) shv[mi][j] = *(const f32x4*)(mod + (size_t)mi * 6144 + 3072 + l3 * 16 + 4 * j);
            for (int col = gw; col < DFF; col += NGW) {
                const bf16_t* wr_ = W1T + (size_t)col * D + l3 * 16; const u32x4 w0 = *(const u32x4*)wr_, w1 = *(const u32x4*)(wr_ + 8);
                float w[16];
                w[0] = bflo(w0.x); w[1] = bfhi(w0.x); w[2] = bflo(w0.y); w[3] = bfhi(w0.y); w[4] = bflo(w0.z); w[5] = bfhi(w0.z); w[6] = bflo(w0.w); w[7] = bfhi(w0.w);
                w[8] = bflo(w1.x); w[9] = bfhi(w1.x); w[10] = bflo(w1.y); w[11] = bfhi(w1.y); w[12] = bflo(w1.z); w[13] = bfhi(w1.z); w[14] = bflo(w1.w); w[15] = bfhi(w1.w);
                float r5[5];
#pragma unroll
                for (int mi = 0; mi < 5; ++mi) { float sacc = 0.f;
#pragma unroll
                    for (int j = 0; j < 4; ++j) sacc += (w[4 * j] * shv[mi][j].x + w[4 * j + 1] * shv[mi][j].y) + (w[4 * j + 2] * shv[mi][j].z + w[4 * j + 3] * shv[mi][j].w);
                    r5[mi] = wave_sum(sacc); }
                if (l3 < 5) bias2[(size_t)l3 * DFF + col] = (l3 == 0) ? r5[0] : (l3 == 1) ? r5[1] : (l3 == 2) ? r5[2] : (l3 == 3) ? r5[3] : r5[4];
            }
        }
    }
    SEAM(1);
    for (int rep = 0; rep < NREP(2); ++rep) if (IN(2)) {
        {   pg8::Gemm g{D, D, D}; SchedInproj S{(const char*)Hb, (const char*)WinT, G, bx};
            EpiInproj E{P, Vt, out_ncv, Qn, Kn, out_nck, A.q_norm_g, A.k_norm_g, (LAS float*)(lds + 131072)};
            pg8::gemm_phase(lds, g, S, E); }
        {   pg8::Gemm g{128, 512, 128}; SchedFourChain S{(const char*)Mt, (const char*)P, G, bx}; EpiFourLocal E{GtC, GtL};
            pg8::gemm_phase(lds, g, S, E); }
    }
    SEAM(2);
    for (int rep = 0; rep < NREP(3); ++rep) if (IN(3)) {
        int l4 = threadIdx.x & 63; asm volatile("" : "+v"(l4));
        const float d1 = wave_sum(A.lq1[l4] * A.lk1[l4]), d2 = wave_sum(A.lq2[l4] * A.lk2[l4]);
        const float gqm = wave_max(fabsf(A.q_norm_g[l4])), gkm = wave_max(fabsf(A.k_norm_g[l4]));
        const float lam = __expf(d1) - __expf(d2) + LAM_INIT;
        float cm = 0.f; for (int i = l4; i < G; i += 64) cm = fmaxf(cm, bmax[i]); cm = wave_max(cm);
        const float qn = 8.f * gqm * QSCALE * 1.01f, knl = 8.f * gkm * 1.01f;
        const float Mb_ctx = qn * knl, Mb_lat = qn * fmaxf(knl, sqrtf(cm) * 1.01f);
        for (int rep2 = 0; rep2 < NREP(10); ++rep2)
        for (int u = bx; u < 512; u += G) {
            const bool lat = u < 256; const int v = u & 255;
            const int b = lat ? (v >> 6) : (v >> 3), h = lat ? ((v >> 4) & 3) : ((v >> 1) & 3), qb = lat ? (v & 15) : (v & 1);
            const size_t tok0 = lat ? (size_t)NCTX + b * LSEQ : (size_t)b * CSEQ;
            AttnSeg s0, s1;
            s1.K = Kn + tok0 * 512 + h * 128; s1.Vt = Vt + (size_t)h * 128 * NTOK + tok0; s1.vstride = NTOK; s1.ntiles = lat ? LSEQ / 128 : CSEQ / 128;
            s0.K = Kc + (size_t)b * PAST * 512 + h * 128; s0.Vt = Vtc + ((size_t)b * 512 + h * 128) * 512; s0.vstride = 512; s0.ntiles = lat ? PAST / 128 : 0;
            if (!lat) { s0.K = s1.K; s0.Vt = s1.Vt; s0.vstride = NTOK; }
            attn_unit(lds, Qn + (tok0 + qb * 128) * 512 + h * 128, s0, s1, lat ? Mb_lat : Mb_ctx, lam, A.subln_g, X2 + (tok0 + qb * 128) * D + h * 128);
        }
        for (int rep2 = 0; rep2 < NREP(11); ++rep2)
        {   pg8::Gemm g{2048, 4096, 512}; SchedPosL S{(const char*)DftL, (const char*)GtL, G, bx}; EpiPlain<0> E{Fpart, 2048};
            pg8::gemm_phase(lds, g, S, E); }
        for (int rep2 = 0; rep2 < NREP(12); ++rep2)
        {   pg8::Gemm g{512, 512, 512}; SchedPosC S{(const char*)DftC, (const char*)GtC, G, bx}; EpiPlain<0> E{X2, D};
            pg8::gemm_phase(lds, g, S, E); }
    }
    SEAM(3);
    for (int rep = 0; rep < NREP(4); ++rep) if (IN(4)) {
        for (int idx = bx * 512 + tid; idx < 1024 * 256; idx += G * 512) { const int n = idx >> 8, c8 = (idx & 255) * 8, b = c8 >> 9, ge = c8 & 511;
            float pc[8] = {0.f, 0.f, 0.f, 0.f, 0.f, 0.f, 0.f, 0.f}, ps[8] = {0.f, 0.f, 0.f, 0.f, 0.f, 0.f, 0.f, 0.f};
#pragma unroll
            for (int z = 0; z < 4; ++z) { const u32x4 w = __builtin_nontemporal_load((const u32x4*)(Fpart + (size_t)z * 2048 * 2048 + (size_t)n * 2048 + c8)), y = __builtin_nontemporal_load((const u32x4*)(Fpart + (size_t)z * 2048 * 2048 + (size_t)(1024 + n) * 2048 + c8));
                pc[0] += bflo(w.x); pc[1] += bfhi(w.x); pc[2] += bflo(w.y); pc[3] += bfhi(w.y); pc[4] += bflo(w.z); pc[5] += bfhi(w.z); pc[6] += bflo(w.w); pc[7] += bfhi(w.w);
                ps[0] += bflo(y.x); ps[1] += bfhi(y.x); ps[2] += bflo(y.y); ps[3] += bfhi(y.y); ps[4] += bflo(y.z); ps[5] += bfhi(y.z); ps[6] += bflo(y.w); ps[7] += bfhi(y.w); }
            u32x4 o; o.x = pk2(pc[0] - ps[0], pc[1] - ps[1]); o.y = pk2(pc[2] - ps[2], pc[3] - ps[3]); o.z = pk2(pc[4] - ps[4], pc[5] - ps[5]); o.w = pk2(pc[6] - ps[6], pc[7] - ps[7]);
            *(u32x4*)(X2 + ((size_t)NCTX + b * LSEQ + n) * D + 512 + ge) = o;
            if (n >= 1) { u32x4 p; p.x = pk2(pc[0] + ps[0], pc[1] + ps[1]); p.y = pk2(pc[2] + ps[2], pc[3] + ps[3]); p.z = pk2(pc[4] + ps[4], pc[5] + ps[5]); p.w = pk2(pc[6] + ps[6], pc[7] + ps[7]);
                *(u32x4*)(X2 + ((size_t)NCTX + b * LSEQ + (LSEQ - n)) * D + 512 + ge) = p; } }
        for (int col = gw; col < 2048; col += NGW) { const bf16_t* gr = GtL + (size_t)col * 4096 + lane * 32; float sacc = 0.f;
#pragma unroll
            for (int j = 0; j < 4; ++j) { const u32x4 w = *(const u32x4*)(gr + 8 * j);
                sacc += (bflo(w.x) - bfhi(w.x)) + (bflo(w.y) - bfhi(w.y)) + (bflo(w.z) - bfhi(w.z)) + (bflo(w.w) - bfhi(w.w)); }
            sacc = wave_sum(sacc) * 0.02209708691207961f;
            if (lane == 0) X2[((size_t)NCTX + (col >> 9) * LSEQ + 1024) * D + 512 + (col & 511)] = (bf16_t)(pk2(sacc, 0.f) & 0xffffu); }
    }
    SEAM(4);
    for (int rep = 0; rep < NREP(5); ++rep) if (IN(5)) {
        pg8::Gemm g{D, D, D}; SchedStd S{(const char*)X2, (const char*)WoutT, 64, 4, (size_t)256 * D * 2, (size_t)256 * D * 2, D, G, bx};
        EpiOut E{A.x_prompt, A.x_sample, mod, A.norm2_g, out_y, A2, ssq};
        pg8::gemm_phase(lds, g, S, E);
    }
    SEAM(5);
    for (int rep = 0; rep < NREP(6); ++rep) if (IN(6)) {
        pg8::Gemm g{D, D, D}; SchedStd S{(const char*)A2, (const char*)W1T, 64, 16, (size_t)256 * D * 2, (size_t)256 * D * 2, DFF, G, bx};
        EpiUp E{U, ssq, bias2};
        pg8::gemm_phase(lds, g, S, E);
    }
    SEAM(6);
    for (int rep = 0; rep < NREP(7); ++rep) if (IN(7)) {
        pg8::Gemm g{DFF, DFF, DFF}; SchedStd S{(const char*)U, (const char*)W2T, 64, 4, (size_t)256 * DFF * 2, (size_t)256 * DFF * 2, D, G, bx};
        EpiResid E{out_y, out_y + (size_t)NCTX * D, mod + 5120, out_y};
        pg8::gemm_phase(lds, g, S, E);
    }
#undef IN
#undef SEAM
}

extern "C" void kernel_launch(void* const* d_in, const int* in_sizes, int n_in, void* d_out, int out_size, void* d_ws, size_t ws_size, hipStream_t stream) {
    static int grid = 0;
    if (grid == 0) {
        if (n_in != 22 || ws_size < WS_END) { fprintf(stderr, "kernel_launch: need 22 inputs and >= %zu bytes of workspace; got %d, %zu\n", (size_t)WS_END, n_in, ws_size); grid = -1; return; }
        int dev = 0, cus = 0, per_cu = 0;
        hipGetDevice(&dev); hipDeviceGetAttribute(&cus, hipDeviceAttributeMultiprocessorCount, dev);
        hipFuncSetAttribute((const void*)fwd_kernel<true>, hipFuncAttributeMaxDynamicSharedMemorySize, LDS_BYTES);
        hipFuncSetAttribute((const void*)fwd_kernel<false>, hipFuncAttributeMaxDynamicSharedMemorySize, LDS_BYTES);
        hipOccupancyMaxActiveBlocksPerMultiprocessor(&per_cu, (const void*)fwd_kernel<true>, 512, LDS_BYTES);
        if (per_cu < 1) { fprintf(stderr, "kernel_launch: occupancy query says %d blocks per CU\n", per_cu); per_cu = 1; }
        (void)hipGetLastError();
        grid = cus * (per_cu > 1 ? 1 : per_cu);
        if (grid > 256) grid = 256;
    }
    if (grid < 0) return;
    Args a{};
    const float** f = (const float**)&a;
    for (int i = 0; i < 22; ++i) f[i] = (const float*)d_in[i];
    a.out = (float*)d_out; a.ws = (unsigned char*)d_ws;
#if ONE_LAUNCH
    hipMemsetAsync((char*)d_ws + WS_BAR, 0, 16384, stream);
    a.ph_lo = 0; a.ph_hi = NPH;
    void* args[] = {&a};
    hipError_t e = hipLaunchCooperativeKernel((const void*)fwd_kernel<true>, dim3(grid), dim3(512), args, LDS_BYTES, stream);
    if (e != hipSuccess) fprintf(stderr, "cooperative launch failed: %s (grid %d)\n", hipGetErrorString(e), grid);
#else
    for (int p = 0; p < NPH; ++p) { a.ph_lo = p; a.ph_hi = p + 1; hipLaunchKernelGGL(fwd_kernel<false>, dim3(grid), dim3(512), LDS_BYTES, stream, a); }
#endif
}
```

```cpp
#include <hip/hip_runtime.h>
#include <hip/hip_cooperative_groups.h>
#include <cstdio>
#include <cstdint>
namespace cg = cooperative_groups;

#define LAS __attribute__((address_space(3)))
typedef unsigned short bf16_t;
typedef short bf16x8 __attribute__((ext_vector_type(8)));
typedef float f32x4 __attribute__((ext_vector_type(4)));
typedef float f32x16 __attribute__((ext_vector_type(16)));
typedef unsigned u32x4 __attribute__((ext_vector_type(4)));
typedef unsigned u32x2 __attribute__((ext_vector_type(2)));

#ifndef REPMASK
#define REPMASK 0
#endif
#define NREP(k) (1 + ((REPMASK >> (k)) & 1))
#ifndef ONE_LAUNCH
#define ONE_LAUNCH 1
#endif

constexpr int D = 1024, NTOK = 16384, NCTX = 8192, LSEQ = 2048, CSEQ = 256, PAST = 512, DFF = 4096, PW = 1536  ;
constexpr int NPH = 8;
constexpr float EPS = 1e-6f;
constexpr float QSCALE = 0.125f * 1.4426950408889634f;
constexpr float LAM_INIT = 0.2f;

constexpr size_t MiB = 1u << 20;
constexpr size_t WS_MOD = 0;
constexpr size_t WS_BAR = 256 * 1024;
constexpr size_t WS_BMAX = 512 * 1024;
constexpr size_t WS_BIAS2 = 640 * 1024;
constexpr size_t WS_WIN = 1 * MiB, WS_WOUT = 5 * MiB, WS_W1 = 7 * MiB, WS_W2 = 15 * MiB, WS_MT = 23 * MiB, WS_DFTC = 24 * MiB;
constexpr size_t WS_H = 25 * MiB;
constexpr size_t WS_X2 = WS_H;
constexpr size_t WS_A2 = 57 * MiB;
constexpr size_t WS_P = 57 * MiB;
constexpr size_t WS_FPART = 57 * MiB;
constexpr size_t WS_VT = 105 * MiB;
constexpr size_t WS_U = 121 * MiB;
constexpr size_t WS_DFTL = 121 * MiB;
constexpr size_t WS_KC = 137 * MiB, WS_VTC = 139 * MiB;
constexpr size_t WS_QN = 141 * MiB, WS_KN = 157 * MiB;
constexpr size_t WS_GTL = 173 * MiB;
constexpr size_t WS_GTC = 189 * MiB;
constexpr size_t WS_SSQ = 249 * MiB;
constexpr size_t WS_END = 250 * MiB;

constexpr int LDS_BYTES = 147456;

__device__ __forceinline__ unsigned pk2(float lo, float hi) {
    typedef __bf16 bf2 __attribute__((ext_vector_type(2))); typedef float f2 __attribute__((ext_vector_type(2)));
    f2 v = {lo, hi}; return __builtin_bit_cast(unsigned, __builtin_convertvector(v, bf2));
}
__device__ __forceinline__ float bflo(unsigned w) { return __builtin_bit_cast(float, w << 16); }
__device__ __forceinline__ float bfhi(unsigned w) { return __builtin_bit_cast(float, w & 0xffff0000u); }
__device__ __forceinline__ float wave_sum(float v) {
#pragma unroll
    for (int o = 1; o < 64; o <<= 1) v += __shfl_xor(v, o);
    return v;
}
__device__ __forceinline__ float wave_max(float v) {
#pragma unroll
    for (int o = 1; o < 64; o <<= 1) v = fmaxf(v, __shfl_xor(v, o));
    return v;
}
#define LDS_WAIT() asm volatile("s_waitcnt lgkmcnt(0)" ::: "memory")

namespace pg8 {
constexpr int BM = 256, BK = 64, HALF = 128, HTB = HALF * BK * 2, STAGE_BYTES = 8 * HTB, NXCD = 8, WGM = 8;
__host__ __device__ __forceinline__ int lds_byte(int r, int c) { const int st = (r >> 4) * 2 + (c >> 5), rr = r & 15, cc = c & 31, ob = rr * 64 + cc * 2; return st * 1024 + (ob ^ (((ob >> 9) & 1) << 5)); }
__host__ __device__ __forceinline__ void stage_rc(int b, int& R, int& C) { const int st = b / 1024, sb = b % 1024, swz = sb ^ (((sb >> 9) & 1) << 5); R = (st >> 1) * 16 + swz / 64; C = (st & 1) * 32 + (swz % 64) / 2; }
__host__ __device__ __forceinline__ int perm32(int rho) { const int n = rho >> 4, i = rho & 15; return 8 * (i >> 2) + 4 * n + (i & 3); }

struct Unit { int pm, pn, z, pad; const char* a; const char* b; size_t coff; };
struct Gemm { int lda, ldb, K; };

__device__ __forceinline__ void tile_order(int L, int nM, int nN, int& pm, int& pn) {
    const int nwg = nM * nN; int wgid = L;
    { const int q = nwg / NXCD, r = nwg % NXCD, xcd = wgid % NXCD, off = wgid / NXCD; wgid = (xcd < r ? xcd * (q + 1) : r * (q + 1) + (xcd - r) * q) + off; }
    const int nig = WGM * nN, gid = wgid / nig, fm = gid * WGM, gsz = (nM - fm) < WGM ? (nM - fm) : WGM;
    pm = fm + ((wgid % nig) % gsz); pn = (wgid % nig) / gsz;
}

template <class Epi, class Sched>
__device__ __forceinline__ void gemm_phase(LAS unsigned char* lds, const Gemm g, const Sched& S, const Epi& E) {
    int tid = threadIdx.x; asm volatile("" : "+v"(tid));
    const int wid = __builtin_amdgcn_readfirstlane(tid >> 6), lane = tid & 63, wr = wid >> 2, wc = wid & 3, fr = lane & 15, fq = lane >> 4;
    int K = g.K; asm volatile("" : "+s"(K)); const int nt = K / BK;
    unsigned voffA[2], voffB[2];
#pragma unroll
    for (int i = 0; i < 2; ++i) { int R, C; stage_rc(tid * 16 + i * 8192, R, C); const int Rb = (R & ~31) + perm32(R & 31);
        voffA[i] = (unsigned)(R * g.lda + C) * 2u; voffB[i] = (unsigned)(Rb * g.ldb + C) * 2u; }
    const size_t kstep = (size_t)(BK * 2);
    const size_t hA = (size_t)HALF * g.lda * 2, hB = (size_t)HALF * g.ldb * 2;
    const unsigned ldsw = (unsigned)wid * 1024u;
    const int aoff = lds_byte(wr * 64 + fr, fq * 8), boff = lds_byte(wc * 32 + fr, fq * 8);
#define PG8_SA(b, h) (((b) * 2 + (h)) * HTB)
#define PG8_SB(b, h) ((4 + (b) * 2 + (h)) * HTB)
#define PG8_STAGE(bufoff, gbase, voff) do { _Pragma("unroll") for (int _i = 0; _i < 2; ++_i) \
        __builtin_amdgcn_global_load_lds((const unsigned*)((const char*)(gbase) + (voff)[_i]), (LAS unsigned*)(lds + (bufoff) + ldsw + _i * 8192), 16, 0, 0); } while (0)
#define PG8_LDA(dst, b, h) do { _Pragma("unroll") for (int m = 0; m < 4; ++m) _Pragma("unroll") for (int k = 0; k < 2; ++k) dst[m][k] = *(const LAS bf16x8*)(lds + PG8_SA(b, h) + aoff + m * 2048 + k * 1024); } while (0)
#define PG8_LDB(dst, b, h) do { _Pragma("unroll") for (int n = 0; n < 2; ++n) _Pragma("unroll") for (int k = 0; k < 2; ++k) dst[n][k] = *(const LAS bf16x8*)(lds + PG8_SB(b, h) + boff + n * 2048 + k * 1024); } while (0)
#define PG8_MMA(ai, bj, At, Bt) do { __builtin_amdgcn_s_setprio(1); _Pragma("unroll") for (int m = 0; m < 4; ++m) _Pragma("unroll") for (int n = 0; n < 2; ++n) _Pragma("unroll") for (int k = 0; k < 2; ++k) \
        acc[ai][bj][m][n] = __builtin_amdgcn_mfma_f32_16x16x32_bf16(Bt[n][k], At[m][k], acc[ai][bj][m][n], 0, 0, 0); __builtin_amdgcn_s_setprio(0); } while (0)
#define PG8_WAIT_V(n) asm volatile("s_waitcnt vmcnt(" #n ")" ::: "memory")
#define PG8_WAIT_L(n) asm volatile("s_waitcnt lgkmcnt(" #n ")" ::: "memory")
#define PG8_BAR __builtin_amdgcn_s_barrier()
#define PG8_SCHED __builtin_amdgcn_sched_barrier(0)
    Unit cur, nxt; int ui = 0;
    if (!S.next(0, cur)) return;
    f32x4 acc[2][2][4][2];
#pragma unroll
    for (int a = 0; a < 2; ++a)
#pragma unroll
        for (int b = 0; b < 2; ++b)
#pragma unroll
            for (int m = 0; m < 4; ++m)
#pragma unroll
                for (int n = 0; n < 2; ++n) acc[a][b][m][n] = (f32x4){0.f, 0.f, 0.f, 0.f};
    bf16x8 At[4][2], B0[2][2], B1[2][2];
    const char* cA = cur.a; const char* cB = cur.b;
    PG8_STAGE(PG8_SB(0, 0), cB, voffB); PG8_STAGE(PG8_SB(0, 1), cB + hB, voffB); PG8_STAGE(PG8_SA(0, 0), cA, voffA); PG8_STAGE(PG8_SA(0, 1), cA + hA, voffA);
    if (wr == 1) PG8_BAR;
    PG8_WAIT_V(2); PG8_BAR;
    PG8_STAGE(PG8_SB(1, 0), cB + kstep, voffB); PG8_STAGE(PG8_SA(1, 0), cA + kstep, voffA); PG8_STAGE(PG8_SB(1, 1), cB + hB + kstep, voffB);
    PG8_WAIT_V(6); PG8_BAR;
    for (;;) {
        const bool has_next = S.next(ui + 1, nxt);
        const char* nA = has_next ? nxt.a : cA; const char* nB = has_next ? nxt.b : cB;
        for (int t = 0; t < nt; t += 2) {
            const bool last = (t == nt - 2);
            const char* a1 = cA + (size_t)(t + 1) * kstep;
            const char* a2 = last ? nA : cA + (size_t)(t + 2) * kstep; const char* b2 = last ? nB : cB + (size_t)(t + 2) * kstep;
            const char* a3 = a2 + kstep; const char* b3 = b2 + kstep;
            PG8_LDB(B0, 0, 0); PG8_LDB(B1, 0, 1); PG8_SCHED; PG8_LDA(At, 0, 0); PG8_STAGE(PG8_SA(1, 1), a1 + hA, voffA);
            PG8_WAIT_V(8); PG8_WAIT_L(0); PG8_BAR; PG8_MMA(0, 0, At, B0); PG8_MMA(0, 1, At, B1); PG8_BAR; PG8_SCHED;
            PG8_LDA(At, 0, 1); PG8_STAGE(PG8_SB(0, 0), b2, voffB); PG8_STAGE(PG8_SB(0, 1), b2 + hB, voffB); PG8_STAGE(PG8_SA(0, 0), a2, voffA);
            PG8_WAIT_V(8); PG8_WAIT_L(0); PG8_BAR; PG8_MMA(1, 0, At, B0); PG8_MMA(1, 1, At, B1); PG8_BAR; PG8_SCHED;
            PG8_LDB(B0, 1, 0); PG8_LDB(B1, 1, 1); PG8_SCHED; PG8_LDA(At, 1, 0); PG8_STAGE(PG8_SA(0, 1), a2 + hA, voffA);
            PG8_WAIT_V(8); PG8_WAIT_L(0); PG8_BAR; PG8_MMA(0, 0, At, B0); PG8_MMA(0, 1, At, B1); PG8_BAR; PG8_SCHED;
            PG8_LDA(At, 1, 1); PG8_STAGE(PG8_SB(1, 0), b3, voffB); PG8_STAGE(PG8_SB(1, 1), b3 + hB, voffB); PG8_STAGE(PG8_SA(1, 0), a3, voffA);
            PG8_WAIT_V(8); PG8_WAIT_L(0); PG8_BAR; PG8_MMA(1, 0, At, B0); PG8_MMA(1, 1, At, B1); PG8_BAR; PG8_SCHED;
        }
        if (wr == 0) PG8_BAR;
        E(acc, cur, wr, wc, fr, fq);
        if (!has_next) break;
#pragma unroll
        for (int a = 0; a < 2; ++a)
#pragma unroll
            for (int b = 0; b < 2; ++b)
#pragma unroll
                for (int m = 0; m < 4; ++m)
#pragma unroll
                    for (int n = 0; n < 2; ++n) acc[a][b][m][n] = (f32x4){0.f, 0.f, 0.f, 0.f};
        cur = nxt; cA = nA; cB = nB; ++ui;
        if (wr == 1) PG8_BAR;
    }
    PG8_WAIT_V(0);
    PG8_BAR;
#undef PG8_SA
#undef PG8_SB
#undef PG8_STAGE
#undef PG8_LDA
#undef PG8_LDB
#undef PG8_MMA
#undef PG8_WAIT_V
#undef PG8_WAIT_L
#undef PG8_BAR
#undef PG8_SCHED
}
}
using pg8::Unit;

__device__ __forceinline__ u32x4 pack8(const f32x4 v0, const f32x4 v1) { u32x4 w; w.x = pk2(v0[0], v0[1]); w.y = pk2(v0[2], v0[3]); w.z = pk2(v1[0], v1[1]); w.w = pk2(v1[2], v1[3]); return w; }

template <int ACT> struct EpiPlain {
    bf16_t* O; int ldc;
    __device__ __forceinline__ void operator()(const f32x4 (&acc)[2][2][4][2], const Unit& u, int wr, int wc, int fr, int fq) const {
        bf16_t* base = O + u.coff + (size_t)(wr * 64 + fr) * ldc + wc * 32 + 8 * fq;
#pragma unroll
        for (int ai = 0; ai < 2; ++ai)
#pragma unroll
            for (int m = 0; m < 4; ++m) { bf16_t* rowp = base + (size_t)(ai * 128 + m * 16) * ldc;
#pragma unroll
                for (int bj = 0; bj < 2; ++bj) { f32x4 v0 = acc[ai][bj][m][0], v1 = acc[ai][bj][m][1];
                    if (ACT == 1) {
#pragma unroll
                        for (int j = 0; j < 4; ++j) { const float a = fmaxf(v0[j], 0.f), b = fmaxf(v1[j], 0.f); v0[j] = a * a; v1[j] = b * b; } }
                    *(u32x4*)(rowp + bj * 128) = pack8(v0, v1); } }
    }
};

struct EpiInproj {
    bf16_t* Pf; bf16_t* Vt; float* ncv; bf16_t* Qn; bf16_t* Kn; float* nck; const float* qg; const float* kg; LAS float* xch  ;
    __device__ __forceinline__ void operator()(const f32x4 (&acc)[2][2][4][2], const Unit& u, int wr, int wc, int fr, int fq) const {
        if (u.z == 1) {
            const int vr0 = (u.pn - 4) * 256 + wr * 64 + fr, tok0 = u.pm * 256 + wc * 32 + 8 * fq;
            const bool ctx = (u.pm < 32);
#pragma unroll
            for (int ai = 0; ai < 2; ++ai)
#pragma unroll
                for (int m = 0; m < 4; ++m) { const int vr = vr0 + ai * 128 + m * 16;
#pragma unroll
                    for (int bj = 0; bj < 2; ++bj) { const int tok = tok0 + bj * 128; const f32x4 v0 = acc[ai][bj][m][0], v1 = acc[ai][bj][m][1];
                        *(u32x4*)(Vt + (size_t)vr * NTOK + tok) = pack8(v0, v1);
                        if (ctx) { float* o = ncv + (size_t)tok * 512 + vr;
#pragma unroll
                            for (int j = 0; j < 4; ++j) { __builtin_nontemporal_store(v0[j], o + (size_t)j * 512); __builtin_nontemporal_store(v1[j], o + (size_t)(j + 4) * 512); } } } }
            return;
        }
        if (u.pn >= 6) { EpiPlain<0> e{Pf, 512}; e(acc, u, wr, wc, fr, fq); return; }
        const bool isk = u.pn >= 2, lat = u.pm >= 32; const int part = wc & 1, wid = wr * 4 + wc;
        float g8[2][4];
#pragma unroll
        for (int n = 0; n < 2; ++n)
#pragma unroll
            for (int j = 0; j < 4; ++j) g8[n][j] = (isk ? kg : qg)[32 * part + 8 * fq + 4 * n + j];
        float ssv[2][4][2];
#pragma unroll
        for (int ai = 0; ai < 2; ++ai)
#pragma unroll
            for (int m = 0; m < 4; ++m)
#pragma unroll
                for (int bj = 0; bj < 2; ++bj) { const f32x4 v0 = acc[ai][bj][m][0], v1 = acc[ai][bj][m][1];
                    float sq = (v0.x * v0.x + v0.y * v0.y) + (v0.z * v0.z + v0.w * v0.w) + (v1.x * v1.x + v1.y * v1.y) + (v1.z * v1.z + v1.w * v1.w);
                    sq += __shfl_xor(sq, 16); sq += __shfl_xor(sq, 32); ssv[ai][m][bj] = sq;
                    if (fq == 0) xch[wid * 256 + (ai * 8 + m * 2 + bj) * 16 + fr] = sq; }
        asm volatile("s_waitcnt lgkmcnt(0)" ::: "memory"); __builtin_amdgcn_s_barrier();
        const LAS float* px = xch + (wid ^ 1) * 256;
        float inv8[2][4];
#pragma unroll
        for (int n = 0; n < 2; ++n)
#pragma unroll
            for (int j = 0; j < 4; ++j) inv8[n][j] = exp2f(-(float)(8 * (fq & 1) + 4 * n + j) * (13.287712379549449f / 16.f));
#pragma unroll
        for (int ai = 0; ai < 2; ++ai)
#pragma unroll
            for (int m = 0; m < 4; ++m) { const int r = ai * 128 + wr * 64 + m * 16 + fr; const int T = u.pm * 256 + r;
                const int ntok = (T - NCTX) & (LSEQ - 1); const float pos = (float)(part ? (ntok & 63) : (ntok >> 6));
#pragma unroll
                for (int bj = 0; bj < 2; ++bj) {
                    const float tot = ssv[ai][m][bj] + px[(ai * 8 + m * 2 + bj) * 16 + fr]; const float rstd = rsqrtf(tot * (1.f / 64.f) + EPS);
                    float y[2][4];
#pragma unroll
                    for (int n = 0; n < 2; ++n)
#pragma unroll
                        for (int j = 0; j < 4; ++j) y[n][j] = acc[ai][bj][m][n][j] * rstd * g8[n][j];
                    if (lat) {
#pragma unroll
                        for (int n = 0; n < 2; ++n)
#pragma unroll
                            for (int j = 0; j < 4; ++j) { float sn, cs; __sincosf(pos * inv8[n][j], &sn, &cs); const float pv = __shfl_xor(y[n][j], 32);
                                y[n][j] = (fq >= 2) ? (y[n][j] * cs + pv * sn) : (y[n][j] * cs - pv * sn); }
                    }
                    const size_t o = (size_t)T * 512 + (u.pn & 1) * 256 + bj * 128 + wc * 32 + 8 * fq;
                    if (isk) {
                        u32x4 w; w.x = pk2(y[0][0], y[0][1]); w.y = pk2(y[0][2], y[0][3]); w.z = pk2(y[1][0], y[1][1]); w.w = pk2(y[1][2], y[1][3]);
                        *(u32x4*)(Kn + o) = w;
                        if (!lat) { __builtin_nontemporal_store((f32x4){y[0][0], y[0][1], y[0][2], y[0][3]}, (f32x4*)(nck + o)); __builtin_nontemporal_store((f32x4){y[1][0], y[1][1], y[1][2], y[1][3]}, (f32x4*)(nck + o + 4)); }
                    } else {
                        u32x4 w; w.x = pk2(y[0][0] * QSCALE, y[0][1] * QSCALE); w.y = pk2(y[0][2] * QSCALE, y[0][3] * QSCALE); w.z = pk2(y[1][0] * QSCALE, y[1][1] * QSCALE); w.w = pk2(y[1][2] * QSCALE, y[1][3] * QSCALE);
                        *(u32x4*)(Qn + o) = w;
                    }
                } }
    }
};

struct EpiFourLocal {
    bf16_t* GtC; bf16_t* GtL;
    __device__ __forceinline__ void operator()(const f32x4 (&acc)[2][2][4][2], const Unit& u, int wr, int wc, int fr, int fq) const {
        const int g = u.pn, tt = u.pm; bf16_t* base; int ld, csoff;
        if (tt < 32) { base = GtC + (size_t)((tt * 4 + g) * 128) * 512; ld = 512; csoff = 256; }
        else { const int lt = tt - 32, b = lt >> 3; base = GtL + (size_t)((b * 4 + g) * 128) * 4096 + (lt & 7) * 256; ld = 4096; csoff = 2048; }
        base += wc * 32 + 8 * fq;
#pragma unroll
        for (int ai = 0; ai < 2; ++ai)
#pragma unroll
            for (int m = 0; m < 4; ++m) { const int e = wr * 64 + m * 16 + fr; bf16_t* rowp = base + (size_t)e * ld + ai * csoff;
#pragma unroll
                for (int bj = 0; bj < 2; ++bj) *(u32x4*)(rowp + bj * 128) = pack8(acc[ai][bj][m][0], acc[ai][bj][m][1]); }
    }
};

struct EpiResid {
    const float* Rlo; const float* Rhi; const float* gate  ; float* out;
    __device__ __forceinline__ void operator()(const f32x4 (&acc)[2][2][4][2], const Unit& u, int wr, int wc, int fr, int fq) const {
        const int T0 = u.pm * 256; const int mi = (T0 < NCTX) ? 0 : 1 + ((T0 - NCTX) >> 11);
        const float* R = (T0 < NCTX) ? Rlo + (size_t)T0 * D : Rhi + (size_t)(T0 - NCTX) * D;
        const int c0 = u.pn * 256 + wc * 32 + 8 * fq;
        f32x4 gv[2][2];
#pragma unroll
        for (int bj = 0; bj < 2; ++bj)
#pragma unroll
            for (int n = 0; n < 2; ++n) gv[bj][n] = *(const f32x4*)(gate + (size_t)mi * 6144 + c0 + bj * 128 + 4 * n);
#pragma unroll
        for (int ai = 0; ai < 2; ++ai)
#pragma unroll
        for (int mh = 0; mh < 2; ++mh) {
            f32x4 rv[2][2][2];
#pragma unroll
            for (int ml = 0; ml < 2; ++ml)
#pragma unroll
                for (int bj = 0; bj < 2; ++bj) { const size_t off = (size_t)(ai * 128 + wr * 64 + (2 * mh + ml) * 16 + fr) * D + c0 + bj * 128;
                    rv[ml][bj][0] = __builtin_nontemporal_load((const f32x4*)(R + off)); rv[ml][bj][1] = __builtin_nontemporal_load((const f32x4*)(R + off + 4)); }
#pragma unroll
            for (int ml = 0; ml < 2; ++ml)
#pragma unroll
                for (int bj = 0; bj < 2; ++bj) { const int m = 2 * mh + ml; const size_t off = (size_t)(ai * 128 + wr * 64 + m * 16 + fr) * D + c0 + bj * 128;
                    __builtin_nontemporal_store(rv[ml][bj][0] + gv[bj][0] * acc[ai][bj][m][0], (f32x4*)(out + (size_t)T0 * D + off));
                    __builtin_nontemporal_store(rv[ml][bj][1] + gv[bj][1] * acc[ai][bj][m][1], (f32x4*)(out + (size_t)T0 * D + off + 4)); }
        }
    }
};

struct EpiOut {
    const float* xlo; const float* xhi; const float* mod; const float* n2g; float* out; bf16_t* A2; float* ssq;
    __device__ __forceinline__ void operator()(const f32x4 (&acc)[2][2][4][2], const Unit& u, int wr, int wc, int fr, int fq) const {
        const int T0 = u.pm * 256; const int mi = (T0 < NCTX) ? 0 : 1 + ((T0 - NCTX) >> 11);
        const float* R = (T0 < NCTX) ? xlo + (size_t)T0 * D : xhi + (size_t)(T0 - NCTX) * D;
        const int c0 = u.pn * 256 + wc * 32 + 8 * fq; const float* mrow = mod + (size_t)mi * 6144;
        f32x4 gv[2][2], gm[2][2];
#pragma unroll
        for (int bj = 0; bj < 2; ++bj)
#pragma unroll
            for (int n = 0; n < 2; ++n) { const int c = c0 + bj * 128 + 4 * n; gv[bj][n] = *(const f32x4*)(mrow + 2048 + c); gm[bj][n] = *(const f32x4*)(n2g + c) * (*(const f32x4*)(mrow + 4096 + c) + 1.0f); }
#pragma unroll
        for (int ai = 0; ai < 2; ++ai)
#pragma unroll
            for (int m = 0; m < 4; ++m) { const int r = ai * 128 + wr * 64 + m * 16 + fr; float ss = 0.f;
#pragma unroll
                for (int bj = 0; bj < 2; ++bj) { const size_t off = (size_t)r * D + c0 + bj * 128;
                    const f32x4 x0 = __builtin_nontemporal_load((const f32x4*)(R + off)) + gv[bj][0] * acc[ai][bj][m][0], x1 = __builtin_nontemporal_load((const f32x4*)(R + off + 4)) + gv[bj][1] * acc[ai][bj][m][1];
                    __builtin_nontemporal_store(x0, (f32x4*)(out + (size_t)T0 * D + off)); __builtin_nontemporal_store(x1, (f32x4*)(out + (size_t)T0 * D + off + 4));
                    ss += (x0.x * x0.x + x0.y * x0.y) + (x0.z * x0.z + x0.w * x0.w) + (x1.x * x1.x + x1.y * x1.y) + (x1.z * x1.z + x1.w * x1.w);
                    *(u32x4*)(A2 + (size_t)T0 * D + off) = pack8(x0 * gm[bj][0], x1 * gm[bj][1]); }
                ss += __shfl_xor(ss, 16); ss += __shfl_xor(ss, 32);
                if (fq == 0) ssq[(size_t)(T0 + r) * 16 + u.pn * 4 + wc] = ss; }
    }
};

struct EpiUp {
    bf16_t* U; const float* ssq; const float* bias2;
    __device__ __forceinline__ void operator()(const f32x4 (&acc)[2][2][4][2], const Unit& u, int wr, int wc, int fr, int fq) const {
        const int T0 = u.pm * 256; const int mi = (T0 < NCTX) ? 0 : 1 + ((T0 - NCTX) >> 11);
        const int c0 = u.pn * 256 + wc * 32 + 8 * fq;
        f32x4 bv[2][2];
#pragma unroll
        for (int bj = 0; bj < 2; ++bj)
#pragma unroll
            for (int n = 0; n < 2; ++n) bv[bj][n] = *(const f32x4*)(bias2 + (size_t)mi * DFF + c0 + bj * 128 + 4 * n);
        float rs[2][4];
#pragma unroll
        for (int ai = 0; ai < 2; ++ai)
#pragma unroll
            for (int m = 0; m < 4; ++m) { const f32x4* sp = (const f32x4*)(ssq + (size_t)(T0 + ai * 128 + wr * 64 + m * 16 + fr) * 16); const f32x4 s4 = (sp[0] + sp[1]) + (sp[2] + sp[3]);
                rs[ai][m] = rsqrtf(((s4.x + s4.y) + (s4.z + s4.w)) * (1.f / D) + EPS); }
#pragma unroll
        for (int ai = 0; ai < 2; ++ai)
#pragma unroll
            for (int m = 0; m < 4; ++m) { const int r = ai * 128 + wr * 64 + m * 16 + fr;
                const float rstd = rs[ai][m];
                bf16_t* rowp = U + (size_t)(T0 + r) * DFF + c0;
#pragma unroll
                for (int bj = 0; bj < 2; ++bj) { f32x4 v0 = acc[ai][bj][m][0] * rstd + bv[bj][0], v1 = acc[ai][bj][m][1] * rstd + bv[bj][1];
#pragma unroll
                    for (int j = 0; j < 4; ++j) { const float a = fmaxf(v0[j], 0.f), b = fmaxf(v1[j], 0.f); v0[j] = a * a; v1[j] = b * b; }
                    *(u32x4*)(rowp + bj * 128) = pack8(v0, v1); } }
    }
};

struct SchedStd {
    const char* A; const char* B; int nM, nN; size_t atile, btile  ; int ldc; int G, c;
    __device__ __forceinline__ bool next(int i, Unit& u) const {
        const int L = i * G + c; if (L >= nM * nN) return false;
        pg8::tile_order(L, nM, nN, u.pm, u.pn); u.z = 0; u.pad = 0;
        u.a = A + (size_t)u.pm * atile; u.b = B + (size_t)u.pn * btile; u.coff = (size_t)u.pm * 256 * ldc + (size_t)u.pn * 256; return true;
    }
};
__device__ __forceinline__ bool inproj_slot(int i, int G, int c, int& pm, int& pn) {
    const int vcu = (G % 8 == 0) ? (c % 8) * (G / 8) + c / 8 : c; const int s = i * G + vcu; if (s >= 512) return false;
    pm = (s & 255) >> 2; pn = 4 * (s >> 8) + (s & 3); return true;
}
struct SchedInproj {
    const char* H; const char* W; int G, c;
    __device__ __forceinline__ bool next(int i, Unit& u) const {
        if (!inproj_slot(i, G, c, u.pm, u.pn)) return false; u.pad = 0;
        const char* h = H + (size_t)u.pm * 256 * D * 2; const char* w = W + (size_t)u.pn * 256 * D * 2;
        if (u.pn == 4 || u.pn == 5) { u.z = 1; u.a = w; u.b = h; u.coff = 0; }
        else { u.z = 0; u.a = h; u.b = w; u.coff = (size_t)u.pm * 256 * 512 + (size_t)(u.pn >= 6 ? u.pn - 6 : 0) * 256; }
        return true;
    }
};
struct SchedFourChain {
    const char* Mt; const char* Pf; int G, c;
    __device__ __forceinline__ bool next(int j, Unit& u) const {
        int nf = 0, pm, pn;
        for (int i = 0; inproj_slot(i, G, c, pm, pn); ++i) {
            if (pn >= 6) { if ((j >> 1) == nf) { const int g = 2 * (pn - 6) + (j & 1); u.pm = pm; u.pn = g; u.z = 0; u.pad = 0; u.coff = 0;
                    u.a = Mt + (size_t)g * 256 * 128 * 2; u.b = Pf + ((size_t)pm * 256 * 512 + g * 128) * 2; return true; }
                ++nf; } }
        return false;
    }
};
struct SchedPosL {
    const char* Dft; const char* Gt; int G, c;
    __device__ __forceinline__ bool next(int i, Unit& u) const {
        const int L = i * G + c; if (L >= 256) return false;
        u.z = L & 3; const int t = L >> 2; u.pm = t & 7; u.pn = t >> 3; u.pad = 0;
        u.a = Dft + ((size_t)u.pm * 256 * 2048 + u.z * 512) * 2; u.b = Gt + ((size_t)u.pn * 256 * 4096 + (u.pm >= 4 ? 2048 : 0) + u.z * 512) * 2;
        u.coff = (size_t)u.z * 2048 * 2048 + (size_t)u.pm * 256 * 2048 + u.pn * 256; return true;
    }
};
struct SchedPosC {
    const char* Dft; const char* Gt; int G, c;
    __device__ __forceinline__ bool next(int i, Unit& u) const {
        const int L = i * G + c; if (L >= 64) return false;
        u.pm = 0; u.pn = L; u.z = 0; u.pad = 0; u.a = Dft; u.b = Gt + (size_t)L * 256 * 512 * 2;
        u.coff = (size_t)(L >> 1) * 256 * D + 512 + (L & 1) * 256; return true;
    }
};

struct TrItem { const float* W; bf16_t* WT; int K, N, item; };
__device__ __forceinline__ void transpose_load(const TrItem& t, f32x4 (&v)[8], int lane) {
    const int nblk = t.N / 32, kb = t.item / nblk, nb = t.item % nblk, k0 = 64 * kb, n0 = 32 * nb;
#pragma unroll
    for (int i = 0; i < 8; ++i) v[i] = __builtin_nontemporal_load((const f32x4*)(t.W + (size_t)(k0 + 8 * i + (lane >> 3)) * t.N + n0 + (lane & 7) * 4));
}
__device__ __forceinline__ void transpose_store(const TrItem& t, const f32x4 (&v)[8], LAS float* scr, int lane) {
    const int nblk = t.N / 32, kb = t.item / nblk, nb = t.item % nblk, k0 = 64 * kb, n0 = 32 * nb;
#pragma unroll
    for (int i = 0; i < 8; ++i) { LAS float* d = scr + (8 * i + (lane >> 3)) * 33 + (lane & 7) * 4; d[0] = v[i].x; d[1] = v[i].y; d[2] = v[i].z; d[3] = v[i].w; }
    LDS_WAIT(); asm volatile("" ::: "memory");
    const int c = lane & 7;
#pragma unroll
    for (int j = 0; j < 4; ++j) { const int n = (lane >> 3) + 8 * j; const LAS float* s = scr + (8 * c) * 33 + n;
        u32x4 o; o.x = pk2(s[0 * 33], s[1 * 33]); o.y = pk2(s[2 * 33], s[3 * 33]); o.z = pk2(s[4 * 33], s[5 * 33]); o.w = pk2(s[6 * 33], s[7 * 33]);
        *(u32x4*)(t.WT + (size_t)(n0 + n) * t.K + k0 + 8 * c) = o; }
    LDS_WAIT(); asm volatile("" ::: "memory");
}

struct Args {
    const float *x_prompt, *x_sample, *c, *cache_k, *cache_v, *c_ctx, *w_mod, *b_mod, *norm1_g, *w_in, *q_norm_g, *k_norm_g, *lq1, *lk1, *lq2, *lk2, *subln_g, *w_four, *w_out, *norm2_g, *w1, *w2;
    float* out; unsigned char* ws; int ph_lo, ph_hi;
};

__device__ __forceinline__ void rowpass_h(const float* xlo, const float* xhi, const float* gvec, const float* mod, int sh_off, int sc_off, bf16_t* H, int gw, int NGW, int lane) {
    for (int T0 = gw * 8; T0 < NTOK; T0 += NGW * 8) {
        const float* xr = (T0 < NCTX) ? xlo + (size_t)T0 * D : xhi + (size_t)(T0 - NCTX) * D;
        const int mi = (T0 < NCTX) ? 0 : 1 + ((T0 - NCTX) >> 11);
        const float* mrow = mod + (size_t)mi * 6144;
        f32x4 gm[4], sh[4], v[8][4];
#pragma unroll
        for (int k = 0; k < 8; ++k)
#pragma unroll
            for (int j = 0; j < 4; ++j) v[k][j] = __builtin_nontemporal_load((const f32x4*)(xr + (size_t)k * D) + lane + 64 * j);
#pragma unroll
        for (int j = 0; j < 4; ++j) { const int cidx = 4 * (lane + 64 * j);
            gm[j] = *(const f32x4*)(gvec + cidx) * (*(const f32x4*)(mrow + sc_off + cidx) + 1.0f); sh[j] = *(const f32x4*)(mrow + sh_off + cidx); }
#pragma unroll
        for (int k = 0; k < 8; ++k) {
            float ss = 0.f;
#pragma unroll
            for (int j = 0; j < 4; ++j) ss += (v[k][j].x * v[k][j].x + v[k][j].y * v[k][j].y) + (v[k][j].z * v[k][j].z + v[k][j].w * v[k][j].w);
            const float rstd = rsqrtf(wave_sum(ss) * (1.f / D) + EPS);
#pragma unroll
            for (int j = 0; j < 4; ++j) { const int cidx = 4 * (lane + 64 * j);
                const f32x4 o = v[k][j] * rstd * gm[j] + sh[j];
                u32x2 w; w.x = pk2(o.x, o.y); w.y = pk2(o.z, o.w);
                *(u32x2*)(H + (size_t)(T0 + k) * D + cidx) = w; }
        }
    }
}

struct AttnSeg { const bf16_t* K; const bf16_t* Vt; int vstride; int ntiles; };
constexpr int AT_KB = 34816  , AT_VB = 34816  , AT_K0 = 0, AT_V0 = 2 * AT_KB;
__device__ __forceinline__ void attn_unit(LAS unsigned char* lds, const bf16_t* Qrow0, const AttnSeg s0, const AttnSeg s1, float Mb, float lam, const float* subg, bf16_t* Xrow0) {
    int tid = threadIdx.x; asm volatile("" : "+v"(tid));
    const int wid = tid >> 6, lane = tid & 63, qblk = wid >> 1, st = wid & 1, q = lane & 31, hi = lane >> 5;
    bf16x8 qf[4];
#pragma unroll
    for (int kk = 0; kk < 4; ++kk) qf[kk] = *(const bf16x8*)(Qrow0 + (size_t)(qblk * 32 + q) * 512 + st * 64 + kk * 16 + hi * 8);
    f32x16 oacc[4];
#pragma unroll
    for (int eb = 0; eb < 4; ++eb)
#pragma unroll
        for (int i = 0; i < 16; ++i) oacc[eb][i] = 0.f;
    float lsum = 0.f;
    const int nt = s0.ntiles + s1.ntiles;
    u32x4 kreg[4], vreg[4];
    const int kkey = tid >> 4, kpart = tid & 15;
    const int pir = (q & 0x13) | ((q & 4) << 1) | ((q & 8) >> 1);
#define AT_LOAD(t) do { const bool in0 = (t) < s0.ntiles; const int tl = in0 ? (t) : (t) - s0.ntiles; const bf16_t* Kp = (in0 ? s0.K : s1.K) + (size_t)tl * 128 * 512; \
        const bf16_t* Vp = (in0 ? s0.Vt : s1.Vt) + tl * 128; const int vs = in0 ? s0.vstride : s1.vstride; \
        _Pragma("unroll") for (int i_ = 0; i_ < 4; ++i_) { kreg[i_] = *(const u32x4*)(Kp + (size_t)(kkey + 32 * i_) * 512 + kpart * 8); vreg[i_] = *(const u32x4*)(Vp + (size_t)(kkey + 32 * i_) * vs + kpart * 8); } } while (0)
#define AT_STORE(buf) do { LAS unsigned char* kb_ = lds + AT_K0 + (buf) * AT_KB; LAS unsigned char* vb_ = lds + AT_V0 + (buf) * AT_VB; \
        _Pragma("unroll") for (int i_ = 0; i_ < 4; ++i_) { *(LAS u32x4*)(kb_ + (kkey + 32 * i_) * 272 + kpart * 16) = kreg[i_]; *(LAS u32x4*)(vb_ + (kkey + 32 * i_) * 272 + kpart * 16) = vreg[i_]; } } while (0)
    AT_LOAD(0); AT_STORE(0); __syncthreads();
    for (int t = 0; t < nt; ++t) {
        const int buf = t & 1;
        if (t + 1 < nt) AT_LOAD(t + 1);
#pragma unroll
        for (int sub = 0; sub < 2; ++sub) {
        const LAS unsigned char* kb = lds + AT_K0 + buf * AT_KB + sub * 64 * 272 + st * 128 + hi * 16;
        const LAS unsigned char* vb = lds + AT_V0 + buf * AT_VB + q * 272 + sub * 128 + hi * 16;
        f32x16 sacc[2];
#pragma unroll
        for (int k2 = 0; k2 < 2; ++k2) {
#pragma unroll
            for (int i = 0; i < 16; ++i) sacc[k2][i] = -Mb;
#pragma unroll
            for (int kk = 0; kk < 4; ++kk) { const bf16x8 a = *(const LAS bf16x8*)(kb + (k2 * 32 + pir) * 272 + kk * 32);
                sacc[k2] = __builtin_amdgcn_mfma_f32_32x32x16_bf16(a, qf[kk], sacc[k2], 0, 0, 0); }
        }
        bf16x8 pf[4];
#pragma unroll
        for (int k2 = 0; k2 < 2; ++k2) {
            float p[16];
#pragma unroll
            for (int i = 0; i < 16; ++i) { p[i] = __builtin_amdgcn_exp2f(sacc[k2][i]); lsum += p[i]; }
#pragma unroll
            for (int u = 0; u < 2; ++u) { u32x4 w; w.x = pk2(p[8 * u + 0], p[8 * u + 1]); w.y = pk2(p[8 * u + 2], p[8 * u + 3]); w.z = pk2(p[8 * u + 4], p[8 * u + 5]); w.w = pk2(p[8 * u + 6], p[8 * u + 7]);
                pf[2 * k2 + u] = __builtin_bit_cast(bf16x8, w); }
        }
#pragma unroll
        for (int eb = 0; eb < 4; ++eb)
#pragma unroll
            for (int kk = 0; kk < 4; ++kk) { const bf16x8 a = *(const LAS bf16x8*)(vb + eb * 32 * 272 + kk * 32);
                oacc[eb] = __builtin_amdgcn_mfma_f32_32x32x16_bf16(a, pf[kk], oacc[eb], 0, 0, 0); }
        }
        if (t + 1 < nt) AT_STORE(buf ^ 1);
        __syncthreads();
    }
#undef AT_LOAD
#undef AT_STORE
    const float l = lsum + __shfl_xor(lsum, 32);
    const float scale = (st == 0) ? 1.f / l : -lam / l;
    LAS float* Tq = (LAS float*)(lds + qblk * (32 * 129 * 4));
    if (st == 1) {
#pragma unroll
        for (int eb = 0; eb < 4; ++eb)
#pragma unroll
            for (int i = 0; i < 16; ++i) { const int e = eb * 32 + (i & 3) + 8 * (i >> 2) + 4 * hi; Tq[q * 129 + e] = oacc[eb][i] * scale; }
    }
    __syncthreads();
    if (st == 0) {
        float ss = 0.f;
#pragma unroll
        for (int eb = 0; eb < 4; ++eb)
#pragma unroll
            for (int i = 0; i < 16; ++i) { const int e = eb * 32 + (i & 3) + 8 * (i >> 2) + 4 * hi; const float v = oacc[eb][i] * scale + Tq[q * 129 + e]; oacc[eb][i] = v; ss += v * v; }
        ss += __shfl_xor(ss, 32);
        const float rstd = rsqrtf(ss * (1.f / 128.f) + EPS) * (1.f - LAM_INIT);
#pragma unroll
        for (int eb = 0; eb < 4; ++eb)
#pragma unroll
            for (int i = 0; i < 16; ++i) { const int e = eb * 32 + (i & 3) + 8 * (i >> 2) + 4 * hi; Tq[q * 129 + e] = oacc[eb][i] * rstd; }
    }
    __syncthreads();
    {
        const int l2 = st * 64 + lane;
        const f32x4 g0 = *(const f32x4*)(subg + (l2 & 15) * 8), g1 = *(const f32x4*)(subg + (l2 & 15) * 8 + 4);
#pragma unroll
        for (int it = 0; it < 4; ++it) { const int idx = it * 128 + l2, row = idx >> 4, c8 = (idx & 15) * 8; const LAS float* s = Tq + row * 129 + c8;
            u32x4 w; w.x = pk2(s[0] * g0.x, s[1] * g0.y); w.y = pk2(s[2] * g0.z, s[3] * g0.w); w.z = pk2(s[4] * g1.x, s[5] * g1.y); w.w = pk2(s[6] * g1.z, s[7] * g1.w);
            *(u32x4*)(Xrow0 + (size_t)(qblk * 32 + row) * D + c8) = w; }
    }
    __syncthreads();
}

#define XB_XCNT(j)  (256  + 64 * (j))
#define XB_XSUB(j)  (1280 + 64 * (j))
#define XB_XGEN(j)  (2304 + 64 * (j))
#define XB_TOP      3328
#define XB_TOPGEN   3392
#define XCD_BAR_WORDS 3456
__device__ __forceinline__ unsigned xb_ld(unsigned* p)              { return __hip_atomic_load(p, __ATOMIC_RELAXED, __HIP_MEMORY_SCOPE_AGENT); }
__device__ __forceinline__ unsigned xb_add(unsigned* p, unsigned v) { return __hip_atomic_fetch_add(p, v, __ATOMIC_RELAXED, __HIP_MEMORY_SCOPE_AGENT); }
__device__ __forceinline__ unsigned xb_xcc_id() { return (unsigned)__builtin_amdgcn_s_getreg((3 << 11) | 20) & 0xFu; }
__device__ __forceinline__ void grid_bar(unsigned* bar, volatile LAS unsigned* st) {
    asm volatile("s_waitcnt vmcnt(0) lgkmcnt(0)" ::: "memory");
    __syncthreads();
    if (threadIdx.x == 0) {
        const unsigned x = xb_xcc_id();
        unsigned nloc = st[0], nx = st[1];
        if (nloc == 0u) {
            const unsigned Gt = gridDim.x;
            for (;;) { unsigned sum = 0u, cnt = 0u, mine = 0u;
#pragma unroll
                for (unsigned j = 0; j < 16; ++j) { const unsigned c = xb_ld(&bar[XB_XCNT(j)]); sum += c; cnt += (c > 0u) ? 1u : 0u; mine = (j == x) ? c : mine; }
                if (sum == Gt) { nloc = mine; nx = cnt; break; }
                __builtin_amdgcn_s_sleep(1); }
            st[0] = nloc; st[1] = nx;
        }
        const unsigned old = xb_add(&bar[XB_XSUB(x)], 1u);
        const unsigned gen = old / nloc;
        if (old + 1u == (gen + 1u) * nloc) {
            __builtin_amdgcn_fence(__ATOMIC_RELEASE, "agent");
            asm volatile("s_waitcnt vmcnt(0)" ::: "memory");
            const unsigned og = xb_add(&bar[XB_TOP], 1u);
            const unsigned tg = og / nx;
            if (og + 1u == (tg + 1u) * nx) xb_add(&bar[XB_TOPGEN], 1u);
            else { while (xb_ld(&bar[XB_TOPGEN]) == tg) __builtin_amdgcn_s_sleep(1); }
            __builtin_amdgcn_fence(__ATOMIC_ACQUIRE, "agent");
            xb_add(&bar[XB_XGEN(x)], 1u);
            asm volatile("s_waitcnt vmcnt(0)" ::: "memory");
        } else {
            while (xb_ld(&bar[XB_XGEN(x)]) == gen) __builtin_amdgcn_s_sleep(1);
            __builtin_amdgcn_fence(__ATOMIC_ACQUIRE, "agent");
            asm volatile("s_waitcnt vmcnt(0)" ::: "memory");
        }
    }
    __syncthreads();
}

template <bool COOP>
__global__ void __launch_bounds__(512) fwd_kernel(Args A) {
    extern __shared__ __attribute__((aligned(16))) unsigned char lds_raw[];
    LAS unsigned char* lds = (LAS unsigned char*)lds_raw;
    const int tid = threadIdx.x, lane = tid & 63, wid = __builtin_amdgcn_readfirstlane(tid >> 6);
    const int G = gridDim.x, bx = blockIdx.x;
    const int gw = bx * 8 + wid, NGW = G * 8;
    unsigned char* ws = A.ws;
    float* mod = (float*)(ws + WS_MOD); float* bmax = (float*)(ws + WS_BMAX);
    bf16_t* WinT = (bf16_t*)(ws + WS_WIN); bf16_t* WoutT = (bf16_t*)(ws + WS_WOUT); bf16_t* W1T = (bf16_t*)(ws + WS_W1); bf16_t* W2T = (bf16_t*)(ws + WS_W2);
    bf16_t* Mt = (bf16_t*)(ws + WS_MT); bf16_t* DftC = (bf16_t*)(ws + WS_DFTC); bf16_t* DftL = (bf16_t*)(ws + WS_DFTL);
    bf16_t* Hb = (bf16_t*)(ws + WS_H); bf16_t* X2 = (bf16_t*)(ws + WS_X2); bf16_t* A2 = (bf16_t*)(ws + WS_A2); float* ssq = (float*)(ws + WS_SSQ); float* bias2 = (float*)(ws + WS_BIAS2);
    bf16_t* P = (bf16_t*)(ws + WS_P); bf16_t* Fpart = (bf16_t*)(ws + WS_FPART); bf16_t* Vt = (bf16_t*)(ws + WS_VT); bf16_t* U = (bf16_t*)(ws + WS_U);
    bf16_t* Kc = (bf16_t*)(ws + WS_KC); bf16_t* Vtc = (bf16_t*)(ws + WS_VTC); bf16_t* Qn = (bf16_t*)(ws + WS_QN); bf16_t* Kn = (bf16_t*)(ws + WS_KN);
    bf16_t* GtL = (bf16_t*)(ws + WS_GTL); bf16_t* GtC = (bf16_t*)(ws + WS_GTC);
    float* out_y = A.out; float* out_nck = A.out + (size_t)NTOK * D; float* out_ncv = out_nck + (size_t)NCTX * 512;
    const int lo = A.ph_lo, hi = A.ph_hi;
#define IN(k) (lo <= (k) && (k) < hi)
    unsigned* barw = (unsigned*)(ws + WS_BAR);
    volatile LAS unsigned* bst = (volatile LAS unsigned*)(lds + 139264);
    if (COOP && A.ph_lo < 0) cg::this_grid().sync();
    if (COOP) { if (tid == 0) { bst[0] = 0u; bst[1] = 0u; (void)xb_add(&barw[XB_XCNT(xb_xcc_id())], 1u); } __syncthreads(); }
#define SEAM(k) do { if (COOP && IN(k) && IN((k) + 1)) { for (int rb = 0; rb < NREP(13); ++rb) grid_bar(barw, bst); } } while (0)

    for (int rep = 0; rep < NREP(0); ++rep) if (IN(0)) {
        LAS float* tab = (LAS float*)(lds);
        LAS float* scs = (LAS float*)(lds + 8192);
        LAS float* red = (LAS float*)(lds + 8192 + 20480);
        LAS float* scr = (LAS float*)(lds + 40960 + wid * 8448);
        for (int i = tid; i < 2048; i += 512) tab[i] = cospif((float)i * (1.f / 1024.f));
        {   float cv[10];
#pragma unroll
            for (int j = 0; j < 10; ++j) { const int i = tid + 512 * j, mi = i >> 10, k = i & 1023; const float* src = (mi == 0) ? A.c_ctx + k : A.c + (mi - 1) * 1024 + k; cv[j] = *src; }
#pragma unroll
            for (int j = 0; j < 10; ++j) scs[tid + 512 * j] = cv[j] / (1.f + __expf(-cv[j])); }
        __syncthreads();
        for (int rp = 0; rp < NREP(14); ++rp)
        for (int item = bx; item < 192; item += G) {
            const int cl = tid & 31, kg = tid >> 5, col = item * 32 + cl, kb = kg * 64; float a0 = 0.f, a1 = 0.f, a2 = 0.f, a3 = 0.f, a4 = 0.f;
            float wv[64];
#pragma unroll
            for (int k = 0; k < 64; ++k) wv[k] = __builtin_nontemporal_load(A.w_mod + (size_t)(kb + k) * 6144 + col);
#pragma unroll
            for (int k = 0; k < 64; ++k) { const float w = wv[k]; const int kk = kb + k;
                a0 += scs[kk] * w; a1 += scs[1024 + kk] * w; a2 += scs[2048 + kk] * w; a3 += scs[3072 + kk] * w; a4 += scs[4096 + kk] * w; }
            red[(kg * 5 + 0) * 32 + cl] = a0; red[(kg * 5 + 1) * 32 + cl] = a1; red[(kg * 5 + 2) * 32 + cl] = a2; red[(kg * 5 + 3) * 32 + cl] = a3; red[(kg * 5 + 4) * 32 + cl] = a4;
            __syncthreads();
            if (tid < 160) { const int mi = tid >> 5; float s_ = A.b_mod[item * 32 + cl];
#pragma unroll
                for (int w = 0; w < 16; ++w) s_ += red[(w * 5 + mi) * 32 + cl];
                mod[(size_t)mi * 6144 + item * 32 + cl] = s_; }
            __syncthreads();
        }
        for (int rp = 0; rp < NREP(15); ++rp) {
        for (int rr = bx; rr < 1024; rr += G) { const int r = rr * 2 + (tid >> 8), sn_ = r >> 10, n = r & 1023, n0 = (tid & 255) * 8; float v[8];
            const int idx0 = (n * n0) & 2047; float c_ = tab[idx0], s_ = tab[(idx0 - 512) & 2047]; const float c1 = tab[n], s1 = tab[(n - 512) & 2047];
#pragma unroll
            for (int j = 0; j < 8; ++j) { v[j] = (sn_ ? s_ : c_) * 0.02209708691207961f; const float cn = c_ * c1 - s_ * s1; s_ = s_ * c1 + c_ * s1; c_ = cn; }
            u32x4 w; w.x = pk2(v[0], v[1]); w.y = pk2(v[2], v[3]); w.z = pk2(v[4], v[5]); w.w = pk2(v[6], v[7]);
            *(u32x4*)(DftL + (size_t)r * 2048 + n0) = w; }
        for (int ch = bx * 512 + tid; ch < 16384; ch += G * 512) { const int r = ch >> 6, c0 = (ch & 63) * 8, cs = c0 >> 8, n0 = c0 & 255; float v[8];
#pragma unroll
            for (int j = 0; j < 8; ++j) { const int idx = ((r * (n0 + j)) & 255) * 8; v[j] = (cs ? -tab[(idx - 512) & 2047] : tab[idx]) * 0.0625f; }
            u32x4 w; w.x = pk2(v[0], v[1]); w.y = pk2(v[2], v[3]); w.z = pk2(v[4], v[5]); w.w = pk2(v[6], v[7]);
            *(u32x4*)(DftC + (size_t)r * 512 + c0) = w; }
        {   LAS float* wl = red;
            LAS float* Tt = (LAS float*)(lds + 40960);
            for (int blk = bx; blk < 256; blk += G) { const int combo = blk >> 5, g = combo >> 1, cs = combo & 1, e0 = (blk & 31) * 4;
                __syncthreads();
                wl[tid] = A.w_four[(size_t)g * 16384 + (tid >> 2) * 128 + e0 + (tid & 3)];
                for (int i = tid; i < 16384; i += 512) { const float a_ = (float)(((i & 127) * (i >> 7)) & 127) * (1.f / 64.f); Tt[i] = cs ? sinpif(a_) : cospif(a_); }
                __syncthreads();
                const int el = tid >> 7, c = tid & 127; float s_ = 0.f;
#pragma unroll 8
                for (int ep = 0; ep < 128; ++ep) s_ += Tt[ep * 128 + c] * wl[ep * 4 + el];
                Mt[(size_t)g * 32768 + (size_t)(cs * 128 + e0 + el) * 128 + c] = (bf16_t)(pk2(s_ * 0.08838834764831845f, 0.f) & 0xffffu); }
            __syncthreads();
        }
        }
        float kmax = 0.f;
        constexpr int I_IN = 16 * 64, I_OUT = 16 * 32, I_1 = 16 * 128, I_2 = 64 * 32, I_CV = 4 * 128, I_CK = 4 * PAST;
        constexpr int NITEMS = I_IN + I_OUT + I_1 + I_2 + I_CV + I_CK;
        constexpr int NTR = I_IN + I_OUT + I_1 + I_2 + I_CV;
#define TR_DESC(it_, t_) do { int r_ = (it_); \
            if (r_ < I_IN) { t_.W = A.w_in; t_.WT = WinT; t_.K = D; t_.N = 2048; t_.item = r_; } else { r_ -= I_IN; \
            if (r_ < I_OUT) { t_.W = A.w_out; t_.WT = WoutT; t_.K = D; t_.N = D; t_.item = r_; } else { r_ -= I_OUT; \
            if (r_ < I_1) { t_.W = A.w1; t_.WT = W1T; t_.K = D; t_.N = DFF; t_.item = r_; } else { r_ -= I_1; \
            if (r_ < I_2) { t_.W = A.w2; t_.WT = W2T; t_.K = DFF; t_.N = D; t_.item = r_; } else { r_ -= I_2; \
            const int b_ = r_ >> 7; t_.W = A.cache_v + (size_t)b_ * 512 * 512; t_.WT = Vtc + (size_t)b_ * 512 * 512; t_.K = 512; t_.N = 512; t_.item = r_ & 127; } } } } } while (0)
        for (int rp = 0; rp < NREP(16); ++rp) {
        {   TrItem cur, nxt; f32x4 va[8], vb[8]; int it = gw;
            if (it < NTR) { TR_DESC(it, cur); transpose_load(cur, va, lane); }
            while (it < NTR) {
                const int itn = it + NGW; const bool hn = itn < NTR;
                if (hn) { TR_DESC(itn, nxt); transpose_load(nxt, vb, lane); }
                transpose_store(cur, va, scr, lane);
                if (hn) { cur = nxt;
#pragma unroll
                    for (int i = 0; i < 8; ++i) va[i] = vb[i]; }
                it = itn;
            }
        }
#undef TR_DESC
        for (int r = gw; r < I_CK; r += NGW) {
            const float* src = A.cache_k + (size_t)r * 512 + lane * 8; const f32x4 v0 = __builtin_nontemporal_load((const f32x4*)src), v1 = __builtin_nontemporal_load((const f32x4*)(src + 4));
            float ss = (v0.x * v0.x + v0.y * v0.y) + (v0.z * v0.z + v0.w * v0.w) + (v1.x * v1.x + v1.y * v1.y) + (v1.z * v1.z + v1.w * v1.w);
            ss += __shfl_xor(ss, 1); ss += __shfl_xor(ss, 2); ss += __shfl_xor(ss, 4); kmax = fmaxf(kmax, ss);
            *(u32x4*)(Kc + (size_t)r * 512 + lane * 8) = pack8(v0, v1); }
        }
        kmax = wave_max(kmax);
        __syncthreads();
        if (lane == 0) red[wid] = kmax;
        __syncthreads();
        if (tid == 0) { float m = 0.f; for (int w = 0; w < 8; ++w) m = fmaxf(m, red[w]); bmax[bx] = m; }
        __syncthreads();
    }
    SEAM(0);
    for (int rep = 0; rep < NREP(1); ++rep) if (IN(1)) {
        rowpass_h(A.x_prompt, A.x_sample, A.norm1_g, mod, 0, 1024, Hb, gw, NGW, lane);
        int l3 = threadIdx.x & 63; asm volatile("" : "+v"(l3));
        {
            f32x4 shv[5][4];
#pragma unroll
            for (int mi = 0; mi < 5; ++mi)
#pragma unroll
                for (int j = 0; j < 4; ++j) shv[mi][j] = *(const f32x4*)(mod + (size_t)mi * 6144 + 3072 + l3 * 16 + 4 * j);
            for (int col = gw; col < DFF; col += NGW) {
                const bf16_t* wr_ = W1T + (size_t)col * D + l3 * 16; const u32x4 w0 = *(const u32x4*)wr_, w1 = *(const u32x4*)(wr_ + 8);
                float w[16];
                w[0] = bflo(w0.x); w[1] = bfhi(w0.x); w[2] = bflo(w0.y); w[3] = bfhi(w0.y); w[4] = bflo(w0.z); w[5] = bfhi(w0.z); w[6] = bflo(w0.w); w[7] = bfhi(w0.w);
                w[8] = bflo(w1.x); w[9] = bfhi(w1.x); w[10] = bflo(w1.y); w[11] = bfhi(w1.y); w[12] = bflo(w1.z); w[13] = bfhi(w1.z); w[14] = bflo(w1.w); w[15] = bfhi(w1.w);
                float r5[5];
#pragma unroll
                for (int mi = 0; mi < 5; ++mi) { float sacc = 0.f;
#pragma unroll
                    for (int j = 0; j < 4; ++j) sacc += (w[4 * j] * shv[mi][j].x + w[4 * j + 1] * shv[mi][j].y) + (w[4 * j + 2] * shv[mi][j].z + w[4 * j + 3] * shv[mi][j].w);
                    r5[mi] = wave_sum(sacc); }
                if (l3 < 5) bias2[(size_t)l3 * DFF + col] = (l3 == 0) ? r5[0] : (l3 == 1) ? r5[1] : (l3 == 2) ? r5[2] : (l3 == 3) ? r5[3] : r5[4];
            }
        }
    }
    SEAM(1);
    for (int rep = 0; rep < NREP(2); ++rep) if (IN(2)) {
        {   pg8::Gemm g{D, D, D}; SchedInproj S{(const char*)Hb, (const char*)WinT, G, bx};
            EpiInproj E{P, Vt, out_ncv, Qn, Kn, out_nck, A.q_norm_g, A.k_norm_g, (LAS float*)(lds + 131072)};
            pg8::gemm_phase(lds, g, S, E); }
        {   pg8::Gemm g{128, 512, 128}; SchedFourChain S{(const char*)Mt, (const char*)P, G, bx}; EpiFourLocal E{GtC, GtL};
            pg8::gemm_phase(lds, g, S, E); }
    }
    SEAM(2);
    for (int rep = 0; rep < NREP(3); ++rep) if (IN(3)) {
        int l4 = threadIdx.x & 63; asm volatile("" : "+v"(l4));
        const float d1 = wave_sum(A.lq1[l4] * A.lk1[l4]), d2 = wave_sum(A.lq2[l4] * A.lk2[l4]);
        const float gqm = wave_max(fabsf(A.q_norm_g[l4])), gkm = wave_max(fabsf(A.k_norm_g[l4]));
        const float lam = __expf(d1) - __expf(d2) + LAM_INIT;
        float cm = 0.f;
        for (int base = 0; base < G; base += 256) { float t4[4];
#pragma unroll
            for (int j = 0; j < 4; ++j) { const int idx = base + l4 + 64 * j; t4[j] = bmax[idx < G ? idx : 0]; if (idx >= G) t4[j] = 0.f; }
            cm = fmaxf(cm, fmaxf(fmaxf(t4[0], t4[1]), fmaxf(t4[2], t4[3]))); }
        cm = wave_max(cm);
        const float qn = 8.f * gqm * QSCALE * 1.01f, knl = 8.f * gkm * 1.01f;
        const float Mb_ctx = qn * knl, Mb_lat = qn * fmaxf(knl, sqrtf(cm) * 1.01f);
        for (int rep2 = 0; rep2 < NREP(10); ++rep2)
        for (int u = bx; u < 512; u += G) {
            const bool lat = u < 256; const int v = u & 255;
            const int b = lat ? (v >> 6) : (v >> 3), h = lat ? ((v >> 4) & 3) : ((v >> 1) & 3), qb = lat ? (v & 15) : (v & 1);
            const size_t tok0 = lat ? (size_t)NCTX + b * LSEQ : (size_t)b * CSEQ;
            AttnSeg s0, s1;
            s1.K = Kn + tok0 * 512 + h * 128; s1.Vt = Vt + (size_t)h * 128 * NTOK + tok0; s1.vstride = NTOK; s1.ntiles = lat ? LSEQ / 128 : CSEQ / 128;
            s0.K = Kc + (size_t)b * PAST * 512 + h * 128; s0.Vt = Vtc + ((size_t)b * 512 + h * 128) * 512; s0.vstride = 512; s0.ntiles = lat ? PAST / 128 : 0;
            if (!lat) { s0.K = s1.K; s0.Vt = s1.Vt; s0.vstride = NTOK; }
            attn_unit(lds, Qn + (tok0 + qb * 128) * 512 + h * 128, s0, s1, lat ? Mb_lat : Mb_ctx, lam, A.subln_g, X2 + (tok0 + qb * 128) * D + h * 128);
        }
        for (int rep2 = 0; rep2 < NREP(11); ++rep2)
        {   pg8::Gemm g{2048, 4096, 512}; SchedPosL S{(const char*)DftL, (const char*)GtL, G, bx}; EpiPlain<0> E{Fpart, 2048};
            pg8::gemm_phase(lds, g, S, E); }
        for (int rep2 = 0; rep2 < NREP(12); ++rep2)
        {   pg8::Gemm g{512, 512, 512}; SchedPosC S{(const char*)DftC, (const char*)GtC, G, bx}; EpiPlain<0> E{X2, D};
            pg8::gemm_phase(lds, g, S, E); }
    }
    SEAM(3);
    for (int rep = 0; rep < NREP(4); ++rep) if (IN(4)) {
        for (int idx = bx * 512 + tid; idx < 1024 * 256; idx += G * 512) { const int n = idx >> 8, c8 = (idx & 255) * 8, b = c8 >> 9, ge = c8 & 511;
            float pc[8] = {0.f, 0.f, 0.f, 0.f, 0.f, 0.f, 0.f, 0.f}, ps[8] = {0.f, 0.f, 0.f, 0.f, 0.f, 0.f, 0.f, 0.f};
#pragma unroll
            for (int z = 0; z < 4; ++z) { const u32x4 w = __builtin_nontemporal_load((const u32x4*)(Fpart + (size_t)z * 2048 * 2048 + (size_t)n * 2048 + c8)), y = __builtin_nontemporal_load((const u32x4*)(Fpart + (size_t)z * 2048 * 2048 + (size_t)(1024 + n) * 2048 + c8));
                pc[0] += bflo(w.x); pc[1] += bfhi(w.x); pc[2] += bflo(w.y); pc[3] += bfhi(w.y); pc[4] += bflo(w.z); pc[5] += bfhi(w.z); pc[6] += bflo(w.w); pc[7] += bfhi(w.w);
                ps[0] += bflo(y.x); ps[1] += bfhi(y.x); ps[2] += bflo(y.y); ps[3] += bfhi(y.y); ps[4] += bflo(y.z); ps[5] += bfhi(y.z); ps[6] += bflo(y.w); ps[7] += bfhi(y.w); }
            u32x4 o; o.x = pk2(pc[0] - ps[0], pc[1] - ps[1]); o.y = pk2(pc[2] - ps[2], pc[3] - ps[3]); o.z = pk2(pc[4] - ps[4], pc[5] - ps[5]); o.w = pk2(pc[6] - ps[6], pc[7] - ps[7]);
            *(u32x4*)(X2 + ((size_t)NCTX + b * LSEQ + n) * D + 512 + ge) = o;
            if (n >= 1) { u32x4 p; p.x = pk2(pc[0] + ps[0], pc[1] + ps[1]); p.y = pk2(pc[2] + ps[2], pc[3] + ps[3]); p.z = pk2(pc[4] + ps[4], pc[5] + ps[5]); p.w = pk2(pc[6] + ps[6], pc[7] + ps[7]);
                *(u32x4*)(X2 + ((size_t)NCTX + b * LSEQ + (LSEQ - n)) * D + 512 + ge) = p; } }
        for (int col = gw; col < 2048; col += NGW) { const bf16_t* gr = GtL + (size_t)col * 4096 + lane * 32; float sacc = 0.f;
#pragma unroll
            for (int j = 0; j < 4; ++j) { const u32x4 w = *(const u32x4*)(gr + 8 * j);
                sacc += (bflo(w.x) - bfhi(w.x)) + (bflo(w.y) - bfhi(w.y)) + (bflo(w.z) - bfhi(w.z)) + (bflo(w.w) - bfhi(w.w)); }
            sacc = wave_sum(sacc) * 0.02209708691207961f;
            if (lane == 0) X2[((size_t)NCTX + (col >> 9) * LSEQ + 1024) * D + 512 + (col & 511)] = (bf16_t)(pk2(sacc, 0.f) & 0xffffu); }
    }
    SEAM(4);
    for (int rep = 0; rep < NREP(5); ++rep) if (IN(5)) {
        pg8::Gemm g{D, D, D}; SchedStd S{(const char*)X2, (const char*)WoutT, 64, 4, (size_t)256 * D * 2, (size_t)256 * D * 2, D, G, bx};
        EpiOut E{A.x_prompt, A.x_sample, mod, A.norm2_g, out_y, A2, ssq};
        pg8::gemm_phase(lds, g, S, E);
    }
    SEAM(5);
    for (int rep = 0; rep < NREP(6); ++rep) if (IN(6)) {
        pg8::Gemm g{D, D, D}; SchedStd S{(const char*)A2, (const char*)W1T, 64, 16, (size_t)256 * D * 2, (size_t)256 * D * 2, DFF, G, bx};
        EpiUp E{U, ssq, bias2};
        pg8::gemm_phase(lds, g, S, E);
    }
    SEAM(6);
    for (int rep = 0; rep < NREP(7); ++rep) if (IN(7)) {
        pg8::Gemm g{DFF, DFF, DFF}; SchedStd S{(const char*)U, (const char*)W2T, 64, 4, (size_t)256 * DFF * 2, (size_t)256 * DFF * 2, D, G, bx};
        EpiResid E{out_y, out_y + (size_t)NCTX * D, mod + 5120, out_y};
        pg8::gemm_phase(lds, g, S, E);
    }
#undef IN
#undef SEAM
}

extern "C" void kernel_launch(void* const* d_in, const int* in_sizes, int n_in, void* d_out, int out_size, void* d_ws, size_t ws_size, hipStream_t stream) {
    static int grid = 0;
    if (grid == 0) {
        if (n_in != 22 || ws_size < WS_END) { fprintf(stderr, "kernel_launch: need 22 inputs and >= %zu bytes of workspace; got %d, %zu\n", (size_t)WS_END, n_in, ws_size); grid = -1; return; }
        int dev = 0, cus = 0, per_cu = 0;
        hipGetDevice(&dev); hipDeviceGetAttribute(&cus, hipDeviceAttributeMultiprocessorCount, dev);
        hipFuncSetAttribute((const void*)fwd_kernel<true>, hipFuncAttributeMaxDynamicSharedMemorySize, LDS_BYTES);
        hipFuncSetAttribute((const void*)fwd_kernel<false>, hipFuncAttributeMaxDynamicSharedMemorySize, LDS_BYTES);
        hipOccupancyMaxActiveBlocksPerMultiprocessor(&per_cu, (const void*)fwd_kernel<true>, 512, LDS_BYTES);
        if (per_cu < 1) { fprintf(stderr, "kernel_launch: occupancy query says %d blocks per CU\n", per_cu); per_cu = 1; }
        (void)hipGetLastError();
        grid = cus * (per_cu > 1 ? 1 : per_cu);
        if (grid > 256) grid = 256;
    }
    if (grid < 0) return;
    Args a{};
    const float** f = (const float**)&a;
    for (int i = 0; i < 22; ++i) f[i] = (const float*)d_in[i];
    a.out = (float*)d_out; a.ws = (unsigned char*)d_ws;
#if ONE_LAUNCH
    hipMemsetAsync((char*)d_ws + WS_BAR, 0, 16384, stream);
    a.ph_lo = 0; a.ph_hi = NPH;
    void* args[] = {&a};
    hipError_t e = hipLaunchCooperativeKernel((const void*)fwd_kernel<true>, dim3(grid), dim3(512), args, LDS_BYTES, stream);
    if (e != hipSuccess) fprintf(stderr, "cooperative launch failed: %s (grid %d)\n", hipGetErrorString(e), grid);
#else
    for (int p = 0; p < NPH; ++p) { a.ph_lo = p; a.ph_hi = p + 1; hipLaunchKernelGGL(fwd_kernel<false>, dim3(grid), dim3(512), LDS_BYTES, stream, a); }
#endif
}
```
